# Optimizing an MI355X kernel written in HIP

```python
import jax, jax.numpy as jnp
from jax import lax
import numpy as np

D_MODEL = 1024
BATCH = 8
SEQ = 2048
DEPTH = 4
DEC_BATCH = 16
DEC_SEQ = 4096
PAST_LEN = 128

MIX_WIDTH = D_MODEL
D_CONV = MIX_WIDTH // 2
D_FFT = MIX_WIDTH - D_CONV
HEAD_DIM = 64
N_CONV_HEADS = D_CONV // HEAD_DIM
N_FFT_GROUPS = D_FFT // HEAD_DIM
CONV_WIDTH = 3
IN_WIDTH = 3 * D_CONV + D_FFT
D_FF = ((8 * D_MODEL // 3 + 255) // 256) * 256
N_MOD = 6
EPS = 1e-6

kernel_name = "hybrid_conv_fourier_encoder"


def rms_norm(x, g):
    xf = x.astype(jnp.float32)
    y = xf * lax.rsqrt(jnp.mean(xf * xf, axis=-1, keepdims=True) + EPS)
    return (y * g.astype(jnp.float32)).astype(x.dtype)


def centred_depthwise_conv3(u, w, b):
    up = jnp.pad(u, ((0, 0), (1, 1), (0, 0)))
    return up[:, :-2] * w[0] + up[:, 1:-1] * w[1] + up[:, 2:] * w[2] + b


def fourier_groups(f):
    bsz, seq, _ = f.shape
    fg = f.reshape(bsz, seq, N_FFT_GROUPS, HEAD_DIM).astype(jnp.float32)
    out = jnp.fft.fft2(fg, axes=(1, 3)).real
    return out.reshape(bsz, seq, D_FFT).astype(f.dtype)


def run_trunk(x, c, w_ada, b_ada, g_pre_mix, g_post_mix, w_in, conv_w, conv_b,
              g_conv, g_fft, w_out, g_pre_ffn, g_post_ffn, w_gate, w_up, w_down):
    c_act = jax.nn.silu(c)
    for l in range(DEPTH):
        mod = c_act @ w_ada[l] + b_ada[l]
        sh_m, sc_m, gt_m, sh_f, sc_f, gt_f = [m[:, None, :] for m in jnp.split(mod, N_MOD, axis=-1)]

        h = rms_norm(x, g_pre_mix[l]) * (1.0 + sc_m) + sh_m
        z = h @ w_in[l]
        bg = z[..., :D_CONV]
        cg = z[..., D_CONV:2 * D_CONV]
        v = z[..., 2 * D_CONV:3 * D_CONV]
        f = z[..., 3 * D_CONV:]
        conv_out = bg * centred_depthwise_conv3(cg * v, conv_w[l], conv_b[l])
        fft_out = fourier_groups(f)
        merged = jnp.concatenate([rms_norm(conv_out, g_conv[l]), rms_norm(fft_out, g_fft[l])], axis=-1)
        o = merged @ w_out[l]
        x = x + gt_m * rms_norm(o, g_post_mix[l])

        h = rms_norm(x, g_pre_ffn[l]) * (1.0 + sc_f) + sh_f
        ff = (jax.nn.silu(h @ w_gate[l]) * (h @ w_up[l])) @ w_down[l]
        x = x + gt_f * rms_norm(ff, g_post_ffn[l])
    return x


def setup_inputs(seed: int = 0) -> dict:
    key = jax.random.key(seed)
    ks = jax.random.split(key, 20)
    f32 = jnp.float32
    nrm = lambda k, s, scale: jax.random.normal(k, s, f32) * scale
    gain = lambda k, s: 1.0 + 0.05 * jax.random.normal(k, s, f32)
    return {
        "x_prompt": nrm(ks[0], (BATCH, SEQ, D_MODEL), 1.0),
        "x_sample": nrm(ks[1], (DEC_BATCH, DEC_SEQ, D_MODEL), 1.0),
        "c_prompt": nrm(ks[2], (BATCH, D_MODEL), 1.0),
        "c_sample": nrm(ks[3], (DEC_BATCH, D_MODEL), 1.0),
        "w_ada": nrm(ks[4], (DEPTH, D_MODEL, N_MOD * D_MODEL), 0.3 * D_MODEL ** -0.5),
        "b_ada": nrm(ks[5], (DEPTH, N_MOD * D_MODEL), 0.02),
        "g_pre_mix": gain(ks[6], (DEPTH, D_MODEL)),
        "g_post_mix": gain(ks[7], (DEPTH, D_MODEL)),
        "w_in": nrm(ks[8], (DEPTH, D_MODEL, IN_WIDTH), D_MODEL ** -0.5),
        "conv_w": nrm(ks[9], (DEPTH, CONV_WIDTH, D_CONV), CONV_WIDTH ** -0.5),
        "conv_b": nrm(ks[10], (DEPTH, D_CONV), 0.01),
        "g_conv": gain(ks[11], (DEPTH, D_CONV)),
        "g_fft": gain(ks[12], (DEPTH, D_FFT)),
        "w_out": nrm(ks[13], (DEPTH, MIX_WIDTH, D_MODEL), MIX_WIDTH ** -0.5),
        "g_pre_ffn": gain(ks[14], (DEPTH, D_MODEL)),
        "g_post_ffn": gain(ks[15], (DEPTH, D_MODEL)),
        "w_gate": nrm(ks[16], (DEPTH, D_MODEL, D_FF), D_MODEL ** -0.5),
        "w_up": nrm(ks[17], (DEPTH, D_MODEL, D_FF), D_MODEL ** -0.5),
        "w_down": nrm(ks[18], (DEPTH, D_FF, D_MODEL), D_FF ** -0.5),
    }


def reference(x_prompt, x_sample, c_prompt, c_sample, w_ada, b_ada, g_pre_mix, g_post_mix,
              w_in, conv_w, conv_b, g_conv, g_fft, w_out, g_pre_ffn, g_post_ffn,
              w_gate, w_up, w_down):
    y_prompt = run_trunk(x_prompt, c_prompt, w_ada, b_ada, g_pre_mix, g_post_mix, w_in, conv_w,
                         conv_b, g_conv, g_fft, w_out, g_pre_ffn, g_post_ffn, w_gate, w_up, w_down)
    y_sample = run_trunk(x_sample, c_sample, w_ada, b_ada, g_pre_mix, g_post_mix, w_in, conv_w,
                         conv_b, g_conv, g_fft, w_out, g_pre_ffn, g_post_ffn, w_gate, w_up, w_down)
    return (y_prompt, y_sample)
```

```cpp
#include <hip/hip_runtime.h>
#include <hip/hip_cooperative_groups.h>
#include <cstdio>
#include <cstdint>
namespace cg = cooperative_groups;
#ifndef MK_ONE_LAUNCH
#define MK_ONE_LAUNCH 1
#endif
namespace pg8 {
#define PG8_LAS __attribute__((address_space(3)))
typedef unsigned short bf16_t;
typedef short bf16x8 __attribute__((ext_vector_type(8)));
typedef float f32x4 __attribute__((ext_vector_type(4)));
typedef unsigned u32x4 __attribute__((ext_vector_type(4)));
constexpr int BM = 256, BK = 64, HALF = 128, HTB = HALF * BK * 2  , STAGE_BYTES = 8 * HTB, NXCD = 8, WGM = 8;

__host__ __device__ __forceinline__ int lds_byte(int r, int c) { const int st = (r >> 4) * 2 + (c >> 5), rr = r & 15, cc = c & 31, ob = rr * 64 + cc * 2; return st * 1024 + (ob ^ (((ob >> 9) & 1) << 5)); }
__host__ __device__ __forceinline__ void stage_rc(int b, int& R, int& C) { const int st = b / 1024, sb = b % 1024, swz = sb ^ (((sb >> 9) & 1) << 5); R = (st >> 1) * 16 + swz / 64; C = (st & 1) * 32 + (swz % 64) / 2; }
__host__ __device__ __forceinline__ int perm32(int rho) { const int n = rho >> 4, i = rho & 15; return 8 * (i >> 2) + 4 * n + (i & 3); }

struct Unit { int pm, pn; };
struct Gemm { const bf16_t* A; const bf16_t* Bt; int M, N, K; };

struct StaticOrder {
    int nM, nN, nwg, G, c;
    __host__ __device__ void init(int M, int N, int G_, int c_) { nM = M / BM; nN = N / BM; nwg = nM * nN; G = G_; c = c_; }
    __host__ __device__ bool next(int i, Unit& u) const {
        const long L = (long)i * G + c; if (L >= nwg) return false;
        int wgid = (int)L; { const int q = nwg / NXCD, r = nwg % NXCD, xcd = wgid % NXCD, off = wgid / NXCD; wgid = (xcd < r ? xcd * (q + 1) : r * (q + 1) + (xcd - r) * q) + off; }
        const int nig = WGM * nN, gid = wgid / nig, fm = gid * WGM, gsz = (nM - fm) < WGM ? (nM - fm) : WGM;
        u.pm = fm + ((wgid % nig) % gsz); u.pn = (wgid % nig) / gsz; return true;
    }
    __device__ __forceinline__ void a_ready(const Unit&) const {}
    __device__ __forceinline__ void done(const Unit&) const {}
};
__device__ __forceinline__ unsigned cvt_pk_bf16(float lo, float hi) { unsigned r; asm volatile("v_cvt_pk_bf16_f32 %0, %1, %2" : "=v"(r) : "v"(lo), "v"(hi)); return r; }
typedef float f32x2c_t __attribute__((ext_vector_type(2))); typedef __bf16 bf16x2c_t __attribute__((ext_vector_type(2)));
__device__ __forceinline__ unsigned cvt_pk_native(float lo, float hi) { const f32x2c_t v = {lo, hi}; const bf16x2c_t b = __builtin_convertvector(v, bf16x2c_t); return __builtin_bit_cast(unsigned, b); }
__device__ __forceinline__ u32x4 pack8(const f32x4 v0, const f32x4 v1) { u32x4 w; w.x = cvt_pk_native(v0[0], v0[1]); w.y = cvt_pk_native(v0[2], v0[3]); w.z = cvt_pk_native(v1[0], v1[1]); w.w = cvt_pk_native(v1[2], v1[3]); return w; }
__device__ __forceinline__ void store16_wt(const __amdgpu_buffer_rsrc_t rs, unsigned byte_off, const u32x4 v) { __builtin_amdgcn_raw_buffer_store_b128(v, rs, byte_off, 0,   16); }
struct EpiIn {
    static constexpr bool PERM = true, AFTER_DRAIN = false;
    bf16_t *BG, *U, *ZF;
    __device__ __forceinline__ void operator()(const f32x4 (&acc)[2][2][4][2], const Unit& u, int wr, int wc, int fr, int fq) const {
        const int row0 = u.pm * BM + wr * 64 + fr, cl = wc * 32 + 8 * fq;
        if (u.pn < 2) {
#pragma unroll
            for (int ai = 0; ai < 2; ++ai)
#pragma unroll
                for (int m = 0; m < 4; ++m) { bf16_t* rowp = BG + (size_t)(row0 + ai * HALF + m * 16) * 512 + u.pn * 256 + cl;
#pragma unroll
                    for (int bj = 0; bj < 2; ++bj) *(u32x4*)(rowp + bj * HALF) = pack8(acc[ai][bj][m][0], acc[ai][bj][m][1]); }
        } else if (u.pn < 6) {
#pragma unroll
            for (int ai = 0; ai < 2; ++ai)
#pragma unroll
                for (int m = 0; m < 4; ++m) { bf16_t* rowp = U + (size_t)(row0 + ai * HALF + m * 16) * 512 + (u.pn - 2) * 128 + cl;
                    *(u32x4*)rowp = pack8(acc[ai][0][m][0] * acc[ai][1][m][0], acc[ai][0][m][1] * acc[ai][1][m][1]); }
        } else {
#pragma unroll
            for (int ai = 0; ai < 2; ++ai)
#pragma unroll
                for (int m = 0; m < 4; ++m) { bf16_t* rowp = ZF + (size_t)(row0 + ai * HALF + m * 16) * 512 + (u.pn - 6) * 256 + cl;
#pragma unroll
                    for (int bj = 0; bj < 2; ++bj) *(u32x4*)(rowp + bj * HALF) = pack8(acc[ai][bj][m][0], acc[ai][bj][m][1]); }
        }
    }
};
struct EpiOS {
    static constexpr bool PERM = true, AFTER_DRAIN = false;
    bf16_t* O; float* stats;
    __device__ __forceinline__ void operator()(const f32x4 (&acc)[2][2][4][2], const Unit& u, int wr, int wc, int fr, int fq) const {
        const int row0 = u.pm * BM + wr * 64 + fr, cl = wc * 32 + 8 * fq;
#pragma unroll
        for (int ai = 0; ai < 2; ++ai)
#pragma unroll
            for (int m = 0; m < 4; ++m) { const int row = row0 + ai * HALF + m * 16; bf16_t* rowp = O + (size_t)row * 1024 + u.pn * 256 + cl; float s = 0.f;
#pragma unroll
                for (int bj = 0; bj < 2; ++bj) { const f32x4 a = acc[ai][bj][m][0], b = acc[ai][bj][m][1];
                    s += (a[0] * a[0] + a[1] * a[1]) + (a[2] * a[2] + a[3] * a[3]) + (b[0] * b[0] + b[1] * b[1]) + (b[2] * b[2] + b[3] * b[3]);
                    *(u32x4*)(rowp + bj * HALF) = pack8(a, b); }
                { const int ln = fq * 16 + fr;
                  s += __int_as_float(__builtin_amdgcn_ds_bpermute((ln ^ 16) << 2, __float_as_int(s))); s += __int_as_float(__builtin_amdgcn_ds_bpermute((ln ^ 32) << 2, __float_as_int(s))); }
                if (fq == 0) stats[(size_t)row * 16 + u.pn * 4 + wc] = s; }
    }
};
__device__ __forceinline__ float silu_f(float g) { return g * __builtin_amdgcn_rcpf(1.0f + __expf(-g)); }
typedef float f32x2e __attribute__((ext_vector_type(2)));
__device__ __forceinline__ f32x2e silu_mul2(f32x2e g, f32x2e u) {
    f32x2e t = g * (-1.4426950408889634f);
    t.x = __builtin_fminf(t.x, 60.0f); t.y = __builtin_fminf(t.y, 60.0f);
    f32x2e p; p.x = __builtin_amdgcn_exp2f(t.x); p.y = __builtin_amdgcn_exp2f(t.y);
    p = p + 1.0f;
    const float r = __builtin_amdgcn_rcpf(p.x * p.y);
    const f32x2e sw = {p.y, p.x};
    return (g * u) * (sw * r);
}
__device__ __forceinline__ f32x4 silu_mul4(const f32x4 g, const f32x4 u) {
    const f32x2e a = silu_mul2((f32x2e){g[0], g[1]}, (f32x2e){u[0], u[1]}), b = silu_mul2((f32x2e){g[2], g[3]}, (f32x2e){u[2], u[3]});
    return (f32x4){a.x, a.y, b.x, b.y};
}
struct EpiAct {
    static constexpr bool PERM = true, AFTER_DRAIN = false;
    bf16_t* ACT;
    __device__ __forceinline__ void operator()(const f32x4 (&acc)[2][2][4][2], const Unit& u, int wr, int wc, int fr, int fq) const {
        const int row0 = u.pm * BM + wr * 64 + fr, cl = wc * 32 + 8 * fq;
        const __amdgpu_buffer_rsrc_t rs = __builtin_amdgcn_make_buffer_rsrc((void*)ACT, 0, 81920 * 2816 * 2, 0x00020000);
#pragma unroll
        for (int ai = 0; ai < 2; ++ai)
#pragma unroll
            for (int m = 0; m < 4; ++m) { const unsigned off = ((unsigned)(row0 + ai * HALF + m * 16) * 2816u + (unsigned)(u.pn * 128 + cl)) * 2u;
                const f32x4 v0 = silu_mul4(acc[ai][0][m][0], acc[ai][1][m][0]), v1 = silu_mul4(acc[ai][0][m][1], acc[ai][1][m][1]);
                store16_wt(rs, off, pack8(v0, v1)); }
    }
};
struct EpiNull {
    static constexpr bool PERM = true, AFTER_DRAIN = false;
    float* dummy;
    __device__ __forceinline__ void operator()(const f32x4 (&acc)[2][2][4][2], const Unit& u, int wr, int wc, int fr, int fq) const {
        float s = 0.f;
#pragma unroll
        for (int ai = 0; ai < 2; ++ai)
#pragma unroll
            for (int bj = 0; bj < 2; ++bj)
#pragma unroll
                for (int m = 0; m < 4; ++m)
#pragma unroll
                    for (int n = 0; n < 2; ++n) s += (acc[ai][bj][m][n][0] + acc[ai][bj][m][n][1]) + (acc[ai][bj][m][n][2] + acc[ai][bj][m][n][3]);
        if (s == 1.2345678e33f) dummy[u.pm * 256 + fr] = s;
    }
};
template <class Epi, class Sched, bool ALIGN_EPI = false, bool SP2 = false>
__device__ __forceinline__ void gemm_phase(PG8_LAS unsigned char* lds, const Gemm g, const Sched& S, const Epi& E, const int wv_s) {
    int tid_; asm volatile("v_mbcnt_lo_u32_b32 %0, -1, 0\n\tv_mbcnt_hi_u32_b32 %0, -1, %0" : "=v"(tid_)); tid_ += wv_s * 64;
    const int tid = tid_, wid = __builtin_amdgcn_readfirstlane(tid >> 6), lane = tid & 63, wr = wid >> 2, wc = wid & 3, fr = lane & 15, fq = lane >> 4;
    const int K = g.K, nt = K / BK;
    unsigned voffA[2], voffB[2];
#pragma unroll
    for (int i = 0; i < 2; ++i) { int R, C; stage_rc(tid * 16 + i * 8192, R, C); const int Rb = Epi::PERM ? ((R & ~31) + perm32(R & 31)) : R;
        voffA[i] = (unsigned)(R * K + C) * 2u; voffB[i] = (unsigned)(Rb * K + C) * 2u; }
    const size_t kstep = (size_t)(BK * 2);
    const size_t hstep = (size_t)HALF * K * 2;
    const size_t tstep = 2 * hstep;
    const unsigned ldsw = (unsigned)wid * 1024u;
    const int aoff = lds_byte(wr * 64 + fr, fq * 8), boff = lds_byte(wc * 32 + fr, fq * 8);
#define PG8_SA(b, h) (((b) * 2 + (h)) * HTB)
#define PG8_SB(b, h) ((4 + (b) * 2 + (h)) * HTB)
#define PG8_STAGE(bufoff, gbase, voff) do { _Pragma("unroll") for (int _i = 0; _i < 2; ++_i) \
        __builtin_amdgcn_global_load_lds((const unsigned*)((const char*)(gbase) + (voff)[_i]), (PG8_LAS unsigned*)(lds + (bufoff) + ldsw + _i * 8192), 16, 0, 0); } while (0)
#define PG8_LDA(dst, b, h) do { _Pragma("unroll") for (int m = 0; m < 4; ++m) _Pragma("unroll") for (int k = 0; k < 2; ++k) dst[m][k] = *(const PG8_LAS bf16x8*)(lds + PG8_SA(b, h) + aoff + m * 2048 + k * 1024); } while (0)
#define PG8_LDB(dst, b, h) do { _Pragma("unroll") for (int n = 0; n < 2; ++n) _Pragma("unroll") for (int k = 0; k < 2; ++k) dst[n][k] = *(const PG8_LAS bf16x8*)(lds + PG8_SB(b, h) + boff + n * 2048 + k * 1024); } while (0)
#define PG8_MMA(ai, bj, At, Bt) do { __builtin_amdgcn_s_setprio(1); _Pragma("unroll") for (int m = 0; m < 4; ++m) _Pragma("unroll") for (int n = 0; n < 2; ++n) _Pragma("unroll") for (int k = 0; k < 2; ++k) \
        acc[ai][bj][m][n] = __builtin_amdgcn_mfma_f32_16x16x32_bf16(Bt[n][k], At[m][k], acc[ai][bj][m][n], 0, 0, 0); __builtin_amdgcn_s_setprio(0); } while (0)
#define PG8_WAIT_V(n) asm volatile("s_waitcnt vmcnt(" #n ")" ::: "memory")
#define PG8_WAIT_L(n) asm volatile("s_waitcnt lgkmcnt(" #n ")" ::: "memory")
#define PG8_BAR __builtin_amdgcn_s_barrier()
#define PG8_SCHED __builtin_amdgcn_sched_barrier(0)
    Unit cur, nxt; int ui = 0;
    if (!S.next(0, cur)) return;
    f32x4 acc[2][2][4][2];
#pragma unroll
    for (int a = 0; a < 2; ++a)
#pragma unroll
        for (int b = 0; b < 2; ++b)
#pragma unroll
            for (int m = 0; m < 4; ++m)
#pragma unroll
                for (int n = 0; n < 2; ++n) acc[a][b][m][n] = (f32x4){0.f, 0.f, 0.f, 0.f};
    bf16x8 At[4][2], B0[2][2], B1[2][2];
    const char* cA = (const char*)g.A + (size_t)cur.pm * tstep; const char* cB = (const char*)g.Bt + (size_t)cur.pn * tstep;
    S.a_ready(cur);
    if constexpr (SP2) {
        PG8_STAGE(PG8_SB(0, 0), cB, voffB); PG8_STAGE(PG8_SB(0, 1), cB + hstep, voffB); PG8_STAGE(PG8_SA(0, 0), cA, voffA); PG8_STAGE(PG8_SA(0, 1), cA + hstep, voffA);
        if (wr == 1) PG8_BAR;
        PG8_WAIT_V(2); PG8_BAR;
        PG8_STAGE(PG8_SB(1, 0), cB + kstep, voffB); PG8_STAGE(PG8_SA(1, 0), cA + kstep, voffA); PG8_STAGE(PG8_SB(1, 1), cB + hstep + kstep, voffB);
        PG8_WAIT_V(6); PG8_BAR;
    } else {
        PG8_STAGE(PG8_SB(0, 0), cB, voffB); PG8_STAGE(PG8_SA(0, 0), cA, voffA); PG8_STAGE(PG8_SB(0, 1), cB + hstep, voffB); PG8_STAGE(PG8_SA(0, 1), cA + hstep, voffA);
        if (wr == 1) PG8_BAR;
        PG8_WAIT_V(4); PG8_BAR;
        PG8_STAGE(PG8_SB(1, 0), cB + kstep, voffB); PG8_STAGE(PG8_SA(1, 0), cA + kstep, voffA); PG8_STAGE(PG8_SB(1, 1), cB + hstep + kstep, voffB);
        PG8_WAIT_V(6); PG8_BAR;
    }
    for (;;) {
        const bool has_next = S.next(ui + 1, nxt);
        const char* nA = has_next ? (const char*)g.A + (size_t)nxt.pm * tstep : cA; const char* nB = has_next ? (const char*)g.Bt + (size_t)nxt.pn * tstep : cB;
        for (int t = 0; t < nt; t += 2) {
            const bool last = (t == nt - 2);
            const char* a1 = cA + (size_t)(t + 1) * kstep;
            const char* a2 = last ? nA : cA + (size_t)(t + 2) * kstep; const char* b2 = last ? nB : cB + (size_t)(t + 2) * kstep;
            const char* a3 = a2 + kstep; const char* b3 = b2 + kstep;
            if (last && has_next) S.a_ready(nxt);
            if constexpr (SP2) {
            PG8_LDB(B0, 0, 0); PG8_LDB(B1, 0, 1); PG8_SCHED; PG8_LDA(At, 0, 0); PG8_STAGE(PG8_SA(1, 1), a1 + hstep, voffA);
            PG8_WAIT_V(8); PG8_WAIT_L(0); PG8_BAR; PG8_MMA(0, 0, At, B0); PG8_MMA(0, 1, At, B1); PG8_BAR; PG8_SCHED;
            PG8_LDA(At, 0, 1); PG8_STAGE(PG8_SB(0, 0), b2, voffB); PG8_STAGE(PG8_SB(0, 1), b2 + hstep, voffB); PG8_STAGE(PG8_SA(0, 0), a2, voffA);
            PG8_WAIT_V(8); PG8_WAIT_L(0); PG8_BAR; PG8_MMA(1, 0, At, B0); PG8_MMA(1, 1, At, B1); PG8_BAR; PG8_SCHED;
            PG8_LDB(B0, 1, 0); PG8_LDB(B1, 1, 1); PG8_SCHED; PG8_LDA(At, 1, 0); PG8_STAGE(PG8_SA(0, 1), a2 + hstep, voffA);
            PG8_WAIT_V(8); PG8_WAIT_L(0); PG8_BAR; PG8_MMA(0, 0, At, B0); PG8_MMA(0, 1, At, B1); PG8_BAR; PG8_SCHED;
            PG8_LDA(At, 1, 1); PG8_STAGE(PG8_SB(1, 0), b3, voffB); PG8_STAGE(PG8_SB(1, 1), b3 + hstep, voffB); PG8_STAGE(PG8_SA(1, 0), a3, voffA);
            PG8_WAIT_V(8); PG8_WAIT_L(0); PG8_BAR; PG8_MMA(1, 0, At, B0); PG8_MMA(1, 1, At, B1); PG8_BAR; PG8_SCHED;
            } else {
            PG8_LDB(B0, 0, 0); PG8_SCHED; PG8_LDA(At, 0, 0); PG8_STAGE(PG8_SA(1, 1), a1 + hstep, voffA);
            PG8_WAIT_L(8); PG8_BAR; PG8_WAIT_L(0); PG8_MMA(0, 0, At, B0); PG8_BAR; PG8_SCHED;
            PG8_LDB(B1, 0, 1); PG8_STAGE(PG8_SB(0, 0), b2, voffB);
            PG8_BAR; PG8_WAIT_L(0); PG8_MMA(0, 1, At, B1); PG8_BAR;
            PG8_LDA(At, 0, 1); PG8_STAGE(PG8_SA(0, 0), a2, voffA);
            PG8_BAR; PG8_WAIT_L(0); PG8_MMA(1, 0, At, B0); PG8_BAR; PG8_SCHED;
            PG8_STAGE(PG8_SB(0, 1), b2 + hstep, voffB);
            PG8_WAIT_V(6); PG8_BAR; PG8_MMA(1, 1, At, B1); PG8_BAR;
            PG8_LDB(B0, 1, 0); PG8_SCHED; PG8_LDA(At, 1, 0); PG8_STAGE(PG8_SA(0, 1), a2 + hstep, voffA);
            PG8_WAIT_L(8); PG8_BAR; PG8_WAIT_L(0); PG8_MMA(0, 0, At, B0); PG8_BAR; PG8_SCHED;
            PG8_LDB(B1, 1, 1); PG8_STAGE(PG8_SB(1, 0), b3, voffB);
            PG8_BAR; PG8_WAIT_L(0); PG8_MMA(0, 1, At, B1); PG8_BAR;
            PG8_LDA(At, 1, 1); PG8_STAGE(PG8_SA(1, 0), a3, voffA);
            PG8_BAR; PG8_WAIT_L(0); PG8_MMA(1, 0, At, B0); PG8_BAR; PG8_SCHED;
            PG8_STAGE(PG8_SB(1, 1), b3 + hstep, voffB);
            PG8_WAIT_V(6); PG8_BAR; PG8_MMA(1, 1, At, B1); PG8_BAR;
            }
        }
        if constexpr (ALIGN_EPI) { if (wr == 0) PG8_BAR; }
        if constexpr (!Epi::AFTER_DRAIN) { E(acc, cur, wr, wc, fr, fq); S.done(cur); }
        if (!has_next) break;
#pragma unroll
        for (int a = 0; a < 2; ++a)
#pragma unroll
            for (int b = 0; b < 2; ++b)
#pragma unroll
                for (int m = 0; m < 4; ++m)
#pragma unroll
                    for (int n = 0; n < 2; ++n) acc[a][b][m][n] = (f32x4){0.f, 0.f, 0.f, 0.f};
        cur = nxt; cA = nA; cB = nB; ++ui;
        if constexpr (ALIGN_EPI) { if (wr == 1) PG8_BAR; }
    }
    PG8_WAIT_V(0);
    if constexpr (!ALIGN_EPI) { if (wr == 0) PG8_BAR; }
    PG8_BAR;
    if constexpr (Epi::AFTER_DRAIN) { E.fused(acc, cur, wr, wc, fr, fq, lds, wid, lane); S.done(cur); }
#undef PG8_SA
#undef PG8_SB
#undef PG8_STAGE
#undef PG8_LDA
#undef PG8_LDB
#undef PG8_MMA
#undef PG8_WAIT_V
#undef PG8_WAIT_L
#undef PG8_BAR
#undef PG8_SCHED
}
}
#define LAS __attribute__((address_space(3)))
typedef unsigned short bf16;
typedef float f32x4 __attribute__((ext_vector_type(4)));
typedef unsigned v4u __attribute__((ext_vector_type(4)));
typedef unsigned v2u __attribute__((ext_vector_type(2)));
constexpr int D = 1024, M_P = 16384, M_S = 65536, M = M_P + M_S, NB = 24, DEPTH = 4;
constexpr int N_IN = 2048, N_GU = 5632, DFF = 2816;
constexpr float EPS = 1e-6f;
constexpr int NWAVES = 8, NTHREADS = 512;
constexpr int LDS_BYTES = 147456 + 2048;
constexpr int MISC_OFF = 147456;
constexpr size_t WS_WIN = 0;
constexpr size_t WS_WOUT = WS_WIN + (size_t)DEPTH * N_IN * D * 2;
constexpr size_t WS_WGU = WS_WOUT + (size_t)DEPTH * D * D * 2;
constexpr size_t WS_WDN = WS_WGU + (size_t)DEPTH * N_GU * D * 2;
constexpr size_t WS_MOD = WS_WDN + (size_t)DEPTH * D * DFF * 2;
constexpr size_t WS_TW4 = WS_MOD + (size_t)DEPTH * NB * 6 * D * 4;
constexpr size_t WS_TW2 = WS_TW4 + 4096 * 8;
constexpr size_t WS_STATS = WS_TW2 + 2048 * 8;
constexpr size_t WS_RA = WS_STATS + (size_t)M * 16 * 4;
constexpr size_t WS_RB = WS_RA + (size_t)M * D * 2;
constexpr size_t WS_BAR = WS_RB + (size_t)M * DFF * 2 + (size_t)M * D * 2;
constexpr size_t WS_XB = WS_RB + (size_t)M * DFF * 2;
constexpr size_t WS_CNT = WS_BAR + 16384;
constexpr size_t WS_SLOT = WS_CNT + (size_t)16 * 320 * 256;
constexpr size_t WS_END = WS_SLOT + (size_t)16 * M * 4 * 4;
constexpr float C64[64] = {1.000000000e+00f, 9.951847267e-01f, 9.807852804e-01f, 9.569403357e-01f, 9.238795325e-01f, 8.819212643e-01f, 8.314696123e-01f, 7.730104534e-01f, 7.071067812e-01f, 6.343932842e-01f, 5.555702330e-01f, 4.713967368e-01f, 3.826834324e-01f, 2.902846773e-01f, 1.950903220e-01f, 9.801714033e-02f, 6.123233996e-17f, -9.801714033e-02f, -1.950903220e-01f, -2.902846773e-01f, -3.826834324e-01f, -4.713967368e-01f, -5.555702330e-01f, -6.343932842e-01f, -7.071067812e-01f, -7.730104534e-01f, -8.314696123e-01f, -8.819212643e-01f, -9.238795325e-01f, -9.569403357e-01f, -9.807852804e-01f, -9.951847267e-01f, -1.000000000e+00f, -9.951847267e-01f, -9.807852804e-01f, -9.569403357e-01f, -9.238795325e-01f, -8.819212643e-01f, -8.314696123e-01f, -7.730104534e-01f, -7.071067812e-01f, -6.343932842e-01f, -5.555702330e-01f, -4.713967368e-01f, -3.826834324e-01f, -2.902846773e-01f, -1.950903220e-01f, -9.801714033e-02f, -1.836970199e-16f, 9.801714033e-02f, 1.950903220e-01f, 2.902846773e-01f, 3.826834324e-01f, 4.713967368e-01f, 5.555702330e-01f, 6.343932842e-01f, 7.071067812e-01f, 7.730104534e-01f, 8.314696123e-01f, 8.819212643e-01f, 9.238795325e-01f, 9.569403357e-01f, 9.807852804e-01f, 9.951847267e-01f};
constexpr float S64[64] = {0.000000000e+00f, 9.801714033e-02f, 1.950903220e-01f, 2.902846773e-01f, 3.826834324e-01f, 4.713967368e-01f, 5.555702330e-01f, 6.343932842e-01f, 7.071067812e-01f, 7.730104534e-01f, 8.314696123e-01f, 8.819212643e-01f, 9.238795325e-01f, 9.569403357e-01f, 9.807852804e-01f, 9.951847267e-01f, 1.000000000e+00f, 9.951847267e-01f, 9.807852804e-01f, 9.569403357e-01f, 9.238795325e-01f, 8.819212643e-01f, 8.314696123e-01f, 7.730104534e-01f, 7.071067812e-01f, 6.343932842e-01f, 5.555702330e-01f, 4.713967368e-01f, 3.826834324e-01f, 2.902846773e-01f, 1.950903220e-01f, 9.801714033e-02f, 1.224646799e-16f, -9.801714033e-02f, -1.950903220e-01f, -2.902846773e-01f, -3.826834324e-01f, -4.713967368e-01f, -5.555702330e-01f, -6.343932842e-01f, -7.071067812e-01f, -7.730104534e-01f, -8.314696123e-01f, -8.819212643e-01f, -9.238795325e-01f, -9.569403357e-01f, -9.807852804e-01f, -9.951847267e-01f, -1.000000000e+00f, -9.951847267e-01f, -9.807852804e-01f, -9.569403357e-01f, -9.238795325e-01f, -8.819212643e-01f, -8.314696123e-01f, -7.730104534e-01f, -7.071067812e-01f, -6.343932842e-01f, -5.555702330e-01f, -4.713967368e-01f, -3.826834324e-01f, -2.902846773e-01f, -1.950903220e-01f, -9.801714033e-02f};


__device__ __forceinline__ float bf_lo(unsigned v) { return __uint_as_float(v << 16); }
__device__ __forceinline__ float bf_hi(unsigned v) { return __uint_as_float(v & 0xffff0000u); }
__device__ __forceinline__ unsigned pk2(float lo, float hi) { return pg8::cvt_pk_bf16(lo, hi); }
typedef float f32x2_t __attribute__((ext_vector_type(2)));
typedef __bf16 bf16x2_t __attribute__((ext_vector_type(2)));
__device__ __forceinline__ unsigned cvtpk_native(float lo, float hi) { const f32x2_t v = {lo, hi}; const bf16x2_t b = __builtin_convertvector(v, bf16x2_t); return __builtin_bit_cast(unsigned, b); }
__device__ __forceinline__ int hw_tid(int wv_s) { int l; asm volatile("v_mbcnt_lo_u32_b32 %0, -1, 0\n\tv_mbcnt_hi_u32_b32 %0, -1, %0" : "=v"(l)); return wv_s * 64 + l; }
__device__ __forceinline__ float wave_sum(float v) {
#pragma unroll
    for (int o = 1; o < 64; o <<= 1) v += __shfl_xor(v, o);
    return v;
}
template <int CTRL, int RM> __device__ __forceinline__ float dppf(float v) { return __int_as_float(__builtin_amdgcn_update_dpp(0, __float_as_int(v), CTRL, RM, 0xF, false)); }
__device__ __forceinline__ float wave_sum_dpp(float v) {
    v += dppf<0x128, 0xF>(v); v += dppf<0x124, 0xF>(v); v += dppf<0x122, 0xF>(v); v += dppf<0x121, 0xF>(v);
    v += dppf<0x142, 0xA>(v); v += dppf<0x143, 0xC>(v);
    return __int_as_float(__builtin_amdgcn_readlane(__float_as_int(v), 63));
}
__device__ __forceinline__ int row_batch(int r) { return r < M_P ? (r >> 11) : 8 + ((r - M_P) >> 12); }

struct Params { const float* in[19]; float* out; unsigned char* ws; int ph_lo, ph_hi; };

template <int N> __device__ __forceinline__ void fft_dif(float (&re)[N], float (&im)[N]) {
#pragma unroll
    for (int half = N / 2; half >= 1; half >>= 1) {
        const int step = 32 / half;
#pragma unroll
        for (int blk = 0; blk < N; blk += 2 * half) {
#pragma unroll
            for (int j = 0; j < half; ++j) {
                const int i0 = blk + j, i1 = i0 + half, ti = j * step;
                const float ar = re[i0], ai = im[i0], br = re[i1], bi = im[i1];
                re[i0] = ar + br; im[i0] = ai + bi;
                const float dr = ar - br, di = ai - bi;
                if (ti == 0) { re[i1] = dr; im[i1] = di; }
                else if (ti == 16) { re[i1] = di; im[i1] = -dr; }
                else { const float c = C64[ti], s = S64[ti]; re[i1] = dr * c + di * s; im[i1] = di * c - dr * s; }
            }
        }
    }
}
template <int N> __device__ __forceinline__ constexpr int brev(int i) { int r = 0; for (int b = 1, o = N >> 1; b < N; b <<= 1, o >>= 1) if (i & b) r |= o; return r; }

__device__ __forceinline__ void tile_writeout(int K, bf16* WT, int k0, int n0, LAS float* scr, int lane) {
    asm volatile("s_waitcnt lgkmcnt(0)" ::: "memory");
    const int c = lane & 7;
#pragma unroll
    for (int j = 0; j < 4; ++j) { const int n = (lane >> 3) + 8 * j; const LAS float* s = scr + (8 * c) * 33 + n;
        v4u o; o.x = pk2(s[0 * 33], s[1 * 33]); o.y = pk2(s[2 * 33], s[3 * 33]); o.z = pk2(s[4 * 33], s[5 * 33]); o.w = pk2(s[6 * 33], s[7 * 33]);
        *(v4u*)(WT + (size_t)(n0 + n) * K + k0 + 8 * c) = o; }
    asm volatile("s_waitcnt lgkmcnt(0)" ::: "memory");
}
template <class Src> __device__ __forceinline__ void transpose_item(const Src& src, int K, bf16* WT, int k0, int n0, LAS float* scr, int lane) {
#pragma unroll 16
    for (int i = 0; i < 32; ++i) { const int kk = 2 * i + (lane >> 5); scr[kk * 33 + (lane & 31)] = src(k0 + kk, n0 + (lane & 31)); }
    tile_writeout(K, WT, k0, n0, scr, lane);
}
__device__ __forceinline__ void fold_item(const float* W  , const LAS float* T, bf16* WT, int k0, int n0, LAS float* scr, int lane) {
    const int q = n0 + (lane & 31) - 1536, m = q >> 1, part = q & 1, g = m >> 6, mm = m & 63;
    float Tr[64];
#pragma unroll
    for (int j = 0; j < 64; ++j) Tr[j] = T[64 * part + ((j * mm) & 63)];
#pragma unroll 2
    for (int i = 0; i < 32; ++i) { const int kk = 2 * i + (lane >> 5); const f32x4* f = (const f32x4*)(W + (size_t)(k0 + kk) * 2048 + 1536 + 64 * g);
        float s0 = 0.f, s1 = 0.f;
#pragma unroll
        for (int jj = 0; jj < 16; jj += 2) { const f32x4 a = f[jj], b = f[jj + 1];
            s0 += (a[0] * Tr[4 * jj] + a[1] * Tr[4 * jj + 1]) + (a[2] * Tr[4 * jj + 2] + a[3] * Tr[4 * jj + 3]);
            s1 += (b[0] * Tr[4 * jj + 4] + b[1] * Tr[4 * jj + 5]) + (b[2] * Tr[4 * jj + 6] + b[3] * Tr[4 * jj + 7]); }
        scr[kk * 33 + (lane & 31)] = s0 + s1; }
    tile_writeout(D, WT, k0, n0, scr, lane);
}
struct SrcPlain { const float* W; int ldw; __device__ __forceinline__ float operator()(int k, int n) const { return W[(size_t)k * ldw + n]; } };
struct SrcIn { const float* W; const LAS float* T;
    __device__ __forceinline__ float operator()(int k, int n) const {
        const float* wr = W + (size_t)k * 2048;
        if (n < 512) return wr[n];
        if (n < 1536) { const int tt = (n - 512) >> 8, c = (n - 512) & 255; return wr[c < 128 ? 512 + 128 * tt + c : 1024 + 128 * tt + (c - 128)]; }
        return wr[n]; } };
struct SrcGU { const float *Wg, *Wu;
    __device__ __forceinline__ float operator()(int k, int n) const { const int j = n >> 8, c = n & 255; return c < 128 ? Wg[(size_t)k * DFF + 128 * j + c] : Wu[(size_t)k * DFF + 128 * j + (c - 128)]; } };

__device__ __forceinline__ void p0_prep(const Params& P, LAS unsigned char* lds, const int wv_s) {
    int tid_ = hw_tid(wv_s); asm volatile("" : "+v"(tid_));
    const int tid = tid_, lane = tid & 63, wave = __builtin_amdgcn_readfirstlane(tid >> 6);
    unsigned char* ws = P.ws;
    LAS float* T = (LAS float*)(lds + MISC_OFF);
    LAS float* cact = (LAS float*)lds;
    LAS float* red = (LAS float*)(lds + 98304);
    if (tid < 64) { T[tid] = cospif((float)tid * (1.0f / 32.0f)); T[64 + tid] = sinpif((float)tid * (1.0f / 32.0f)); }
    for (int i = tid; i < NB * D; i += NTHREADS) { const int b = i >> 10, k = i & 1023; const float c = b < 8 ? P.in[2][b * D + k] : P.in[3][(b - 8) * D + k]; cact[i] = c / (1.0f + __expf(-c)); }
    __syncthreads();
    float* mod = (float*)(ws + WS_MOD);
    for (int item = blockIdx.x; item < DEPTH * 96; item += gridDim.x) {
        const int l = item / 96, n0 = (item % 96) * 64;
        const float* W = P.in[4] + (size_t)l * D * 6144 + n0 + lane;
        float acc[NB];
#pragma unroll
        for (int b = 0; b < NB; ++b) acc[b] = 0.f;
        const int k0 = wave * 128;
        for (int k = k0; k < k0 + 128; k += 8) {
            float w[8];
#pragma unroll
            for (int i = 0; i < 8; ++i) w[i] = W[(size_t)(k + i) * 6144];
#pragma unroll
            for (int b = 0; b < NB; ++b) { const f32x4 c4 = *(const LAS f32x4*)(cact + b * D + k), c5 = *(const LAS f32x4*)(cact + b * D + k + 4);
                acc[b] += ((c4[0] * w[0] + c4[1] * w[1]) + (c4[2] * w[2] + c4[3] * w[3])) + ((c5[0] * w[4] + c5[1] * w[5]) + (c5[2] * w[6] + c5[3] * w[7])); }
        }
#pragma unroll
        for (int b = 0; b < NB; ++b) red[(wave * NB + b) * 64 + lane] = acc[b];
        __syncthreads();
        for (int o = tid; o < NB * 64; o += NTHREADS) { const int b = o >> 6, n = o & 63; float s = 0.f;
#pragma unroll
            for (int w = 0; w < NWAVES; ++w) s += red[(w * NB + b) * 64 + n];
            mod[(size_t)(l * NB + b) * 6144 + n0 + n] = s + P.in[5][l * 6144 + n0 + n]; }
        __syncthreads();
    }
    if (blockIdx.x == 0) { unsigned* bw = (unsigned*)(ws + WS_BAR); for (int i = tid; i < 3456; i += NTHREADS) bw[i] = 0u; }
    { unsigned* cw = (unsigned*)(ws + WS_CNT); for (int i = blockIdx.x * NTHREADS + tid; i < 16 * 320; i += gridDim.x * NTHREADS) cw[64 * i] = 0u; }
    { float2* tw4 = (float2*)(ws + WS_TW4); float2* tw2 = (float2*)(ws + WS_TW2);
      for (int j = blockIdx.x * NTHREADS + tid; j < 4096 + 2048; j += gridDim.x * NTHREADS) {
          if (j < 4096) { float s, c; sincospif((float)j * (1.0f / 2048.0f), &s, &c); tw4[j] = make_float2(c, -s); }
          else { const int jj = j - 4096; float s, c; sincospif((float)jj * (1.0f / 1024.0f), &s, &c); tw2[jj] = make_float2(c, -s); } } }
}
__device__ __forceinline__ void p0_weights(const Params& P, LAS unsigned char* lds, const int wv_s) {
    int tid_ = hw_tid(wv_s); asm volatile("" : "+v"(tid_));
    const int tid = tid_, lane = tid & 63, wave = __builtin_amdgcn_readfirstlane(tid >> 6);
    unsigned char* ws = P.ws;
    LAS float* T = (LAS float*)(lds + MISC_OFF);
    if (tid < 64) { T[tid] = cospif((float)tid * (1.0f / 32.0f)); T[64 + tid] = sinpif((float)tid * (1.0f / 32.0f)); }
    __syncthreads();
    LAS float* scr = (LAS float*)(lds + wave * 8448);
    const int gw = blockIdx.x * NWAVES + wave, NGW = gridDim.x * NWAVES;
    constexpr int I_IN = 16 * 64, I_OUT = 16 * 32, I_GU = 16 * 176, I_DN = 44 * 32, I_L = I_IN + I_OUT + I_GU + I_DN;
    for (int it = gw; it < DEPTH * I_L; it += NGW) {
        const int l = it / I_L; int r = it % I_L;
        if (r < I_IN) { SrcIn s{P.in[8] + (size_t)l * D * 2048, T}; transpose_item(s, D, (bf16*)(ws + WS_WIN) + (size_t)l * N_IN * D, 64 * (r / 64), 32 * (r % 64), scr, lane); continue; } r -= I_IN;
        if (r < I_OUT) { SrcPlain s{P.in[13] + (size_t)l * D * D, D}; transpose_item(s, D, (bf16*)(ws + WS_WOUT) + (size_t)l * D * D, 64 * (r / 32), 32 * (r % 32), scr, lane); continue; } r -= I_OUT;
        if (r < I_GU) { SrcGU s{P.in[16] + (size_t)l * D * DFF, P.in[17] + (size_t)l * D * DFF}; transpose_item(s, D, (bf16*)(ws + WS_WGU) + (size_t)l * N_GU * D, 64 * (r / 176), 32 * (r % 176), scr, lane); continue; } r -= I_GU;
        { SrcPlain s{P.in[18] + (size_t)l * DFF * D, D}; transpose_item(s, DFF, (bf16*)(ws + WS_WDN) + (size_t)l * D * DFF, 64 * (r / 32), 32 * (r % 32), scr, lane); }
    }
}

#ifndef ROWCOOP
#define ROWCOOP 1
#endif
#ifndef NSETB
#define NSETB 2
#endif
#ifndef XBF16
#define XBF16 1
#endif
template <bool BR, bool DOH, bool LAST, bool FIRST> __device__ __forceinline__ void row_range(const Params& P, const int lane, const int r0, const int r1, const int step  , const float* gpost, const float* modg  ,
                                                                         const float* gpre, const float* modsh, const float* modsc) {
    bf16* RA = (bf16*)(P.ws + WS_RA); const float* stats = (const float*)(P.ws + WS_STATS);
    bf16* XB = (bf16*)(P.ws + WS_XB);
    constexpr bool XOUT32 = !XBF16 || LAST;
    constexpr bool XIN32 = !XBF16 || FIRST;
    constexpr int NSET = XIN32 ? 1 : NSETB;
    if (r0 >= r1) return;
    f32x4 gp[4], gq[4], gb[4], ga[4], sh[4];
#pragma unroll
    for (int j = 0; j < 4; ++j) { if (BR) gp[j] = ((const f32x4*)gpost)[lane + 64 * j]; if (DOH) gq[j] = ((const f32x4*)gpre)[lane + 64 * j]; }
    int gb_cur = -1;
    f32x4 xn[NSET][2][4]; v2u xbn[NSET][2][4]; v2u on[NSET][2][4]; float stn[NSET][2];
    auto xptr = [&](int row) -> const float* { return FIRST ? (row < M_P ? P.in[0] + (size_t)row * D : P.in[1] + (size_t)(row - M_P) * D) : P.out + (size_t)row * D; };
#define ROW_LOAD(s, q, row) do { if ((row) < r1) { const float* xr_ = xptr(row); _Pragma("unroll") for (int j = 0; j < 4; ++j) { \
        if (XIN32) xn[s][q][j] = __builtin_nontemporal_load(((const f32x4*)xr_) + lane + 64 * j); else xbn[s][q][j] = __builtin_nontemporal_load(((const v2u*)(XB + (size_t)(row) * D)) + lane + 64 * j); \
        if (BR) on[s][q][j] = __builtin_nontemporal_load(((const v2u*)(RA + (size_t)(row) * D)) + lane + 64 * j); } \
        if (BR) stn[s][q] = stats[(size_t)(row) * 16 + (lane & 15)]; } } while (0)
#pragma unroll
    for (int s = 0; s < NSET; ++s) { ROW_LOAD(s, 0, r0 + step * s); ROW_LOAD(s, 1, r0 + step * s + 1); }
    for (int rowg = r0; rowg < r1; rowg += step * NSET) {
#pragma unroll
        for (int s = 0; s < NSET; ++s) {
            const int rowp = rowg + step * s;
            f32x4 xc[2][4]; v2u oc[2][4]; float stc[2];
#pragma unroll
            for (int q = 0; q < 2; ++q) {
#pragma unroll
                for (int j = 0; j < 4; ++j) { if (XIN32) xc[q][j] = xn[s][q][j]; else xc[q][j] = (f32x4){bf_lo(xbn[s][q][j].x), bf_hi(xbn[s][q][j].x), bf_lo(xbn[s][q][j].y), bf_hi(xbn[s][q][j].y)}; if (BR) oc[q][j] = on[s][q][j]; }
                if (BR) stc[q] = stn[s][q]; }
            ROW_LOAD(s, 0, rowp + step * NSET); ROW_LOAD(s, 1, rowp + step * NSET + 1);
#pragma unroll
            for (int q = 0; q < 2; ++q) {
                const int row = rowp + q;
                if (row < r1) {
                    const int gbt = row_batch(row);
                    if (gbt != gb_cur) { gb_cur = gbt;
#pragma unroll
                        for (int j = 0; j < 4; ++j) { if (BR) gb[j] = ((const f32x4*)(modg + (size_t)gbt * 6144))[lane + 64 * j] * gp[j];
                            if (DOH) { sh[j] = ((const f32x4*)(modsh + (size_t)gbt * 6144))[lane + 64 * j]; ga[j] = (((const f32x4*)(modsc + (size_t)gbt * 6144))[lane + 64 * j] + 1.0f) * gq[j]; } } }
                    f32x4 x[4];
#pragma unroll
                    for (int j = 0; j < 4; ++j) x[j] = xc[q][j];
                    if (BR) {
                        float ss = stc[q]; ss += dppf<0x128, 0xF>(ss); ss += dppf<0x124, 0xF>(ss); ss += dppf<0x122, 0xF>(ss); ss += dppf<0x121, 0xF>(ss);
                        const float rinv = rsqrtf(ss * (1.0f / D) + EPS);
#pragma unroll
                        for (int j = 0; j < 4; ++j) {
                            const v2u o = oc[q][j];
                            x[j][0] += gb[j][0] * (bf_lo(o.x) * rinv); x[j][1] += gb[j][1] * (bf_hi(o.x) * rinv);
                            x[j][2] += gb[j][2] * (bf_lo(o.y) * rinv); x[j][3] += gb[j][3] * (bf_hi(o.y) * rinv);
                        }
#pragma unroll
                        for (int j = 0; j < 4; ++j) { if (XOUT32) __builtin_nontemporal_store(x[j], ((f32x4*)(P.out + (size_t)row * D)) + lane + 64 * j);
                            else { v2u w; w.x = pk2(x[j][0], x[j][1]); w.y = pk2(x[j][2], x[j][3]); ((v2u*)(XB + (size_t)row * D))[lane + 64 * j] = w;
                                   x[j] = (f32x4){bf_lo(w.x), bf_hi(w.x), bf_lo(w.y), bf_hi(w.y)}; } }
                    }
                    if (DOH) {
                        float s2 = 0.f;
#pragma unroll
                        for (int j = 0; j < 4; ++j) s2 += (x[j][0] * x[j][0] + x[j][1] * x[j][1]) + (x[j][2] * x[j][2] + x[j][3] * x[j][3]);
                        s2 = wave_sum_dpp(s2);
                        const float r2 = rsqrtf(s2 * (1.0f / D) + EPS);
#pragma unroll
                        for (int j = 0; j < 4; ++j) {
                            f32x4 h;
#pragma unroll
                            for (int e = 0; e < 4; ++e) h[e] = (x[j][e] * r2) * ga[j][e] + sh[j][e];
                            v2u w; w.x = pk2(h[0], h[1]); w.y = pk2(h[2], h[3]);
                            ((v2u*)(RA + (size_t)row * D))[lane + 64 * j] = w;
                        }
                    }
                }
            }
        }
    }
#undef ROW_LOAD
}
template <bool BR, bool DOH, bool LAST, bool FIRST> __device__ __forceinline__ void row_phase(const Params& P, const int wv_s, const float* gpost, const float* modg, const float* gpre, const float* modsh, const float* modsc) {
    int tid_ = hw_tid(wv_s); asm volatile("" : "+v"(tid_));
    const int lane = tid_ & 63, wave = __builtin_amdgcn_readfirstlane(tid_ >> 6);
    const int gw = blockIdx.x * NWAVES + wave, NGW = gridDim.x * NWAVES;
    const int rpw = (M + NGW - 1) / NGW, r0 = gw * rpw, r1 = (r0 + rpw < M) ? r0 + rpw : M;
#if ROWCOOP
    { const int rpb = rpw * NWAVES, b0 = blockIdx.x * rpb, b1 = (b0 + rpb < M) ? b0 + rpb : M;
      row_range<BR, DOH, LAST, FIRST>(P, lane, b0 + 2 * wave, b1, 2 * NWAVES, gpost, modg, gpre, modsh, modsc); }
#else
    row_range<BR, DOH, LAST, FIRST>(P, lane, r0, r1, 2, gpost, modg, gpre, modsh, modsc);
#endif
}
__device__ __forceinline__ unsigned gload_row(const void* rowp  , unsigned voff) { unsigned v; asm volatile("global_load_dword %0, %1, %2" : "=v"(v) : "v"(voff), "s"(rowp) : "memory"); return v; }
#define TIE16(a, o) asm volatile("" : "+v"(a[o + 0]), "+v"(a[o + 1]), "+v"(a[o + 2]), "+v"(a[o + 3]), "+v"(a[o + 4]), "+v"(a[o + 5]), "+v"(a[o + 6]), "+v"(a[o + 7]), \
                                      "+v"(a[o + 8]), "+v"(a[o + 9]), "+v"(a[o + 10]), "+v"(a[o + 11]), "+v"(a[o + 12]), "+v"(a[o + 13]), "+v"(a[o + 14]), "+v"(a[o + 15]))
__device__ __forceinline__ void f1_phase(const Params& P, LAS unsigned char* lds, const int wv_s) {
    typedef short bf16x8 __attribute__((ext_vector_type(8)));
    typedef float f32x2v __attribute__((ext_vector_type(2)));
    int tid_ = hw_tid(wv_s); asm volatile("" : "+v"(tid_));
    const int m = tid_, lane = m & 63, wave = __builtin_amdgcn_readfirstlane(m >> 6), l15 = lane & 15, quad = lane >> 4;
    const bf16* F = (const bf16*)(P.ws + WS_RB + (size_t)M * 1024 * 2);
    unsigned* Y = (unsigned*)(P.ws + WS_RA);
    LAS unsigned char* Pl = lds + wave * 16384;
    LAS unsigned char* Dt = lds + 131072;
    LAS f32x2v* ltw = (LAS f32x2v*)(lds + MISC_OFF + 1024);
    for (int i = m; i < 128 * 32; i += NTHREADS) { const int n = i >> 5, j = 2 * (i & 31), mm = n >> 1; float s0, c0, s1, c1;
        sincospif((float)((j * mm) & 63) * (1.0f / 32.0f), &s0, &c0); sincospif((float)(((j + 1) * mm) & 63) * (1.0f / 32.0f), &s1, &c1);
        *(LAS unsigned*)(Dt + n * 128 + j * 2) = (n & 1) ? pk2(-s0, -s1) : pk2(c0, c1); }
    __syncthreads();
    int par = 0;
    for (int item = blockIdx.x; item < 1024 + 256; item += gridDim.x, par ^= 1) {
        int base, N1, t1; const float2* tw;
        if (item < 1024) { base = M_P + (item >> 6) * 4096; t1 = item & 63; N1 = 64; tw = (const float2*)(P.ws + WS_TW4); }
        else { const int it = item - 1024; base = (it >> 5) * 2048; t1 = it & 31; N1 = 32; tw = (const float2*)(P.ws + WS_TW2); }
        if (m < 64) { const float2 w0 = tw[m * t1]; ltw[par * 64 + m] = (f32x2v){w0.x, w0.y}; }
        bf16x8 fb[4][2];
#pragma unroll
        for (int tt = 0; tt < 4; ++tt)
#pragma unroll
            for (int kk = 0; kk < 2; ++kk) fb[tt][kk] = *(const bf16x8*)(F + (size_t)(base + t1 + N1 * (16 * tt + l15)) * 512 + 64 * wave + 32 * kk + 8 * quad);
#pragma unroll
        for (int nt = 0; nt < 8; ++nt) {
            const bf16x8 a0 = *(const LAS bf16x8*)(Dt + (16 * nt + l15) * 128 + (8 * quad) * 2), a1 = *(const LAS bf16x8*)(Dt + (16 * nt + l15) * 128 + (32 + 8 * quad) * 2);
#pragma unroll
            for (int tt = 0; tt < 4; ++tt) {
                f32x4 acc = {0.f, 0.f, 0.f, 0.f};
                acc = __builtin_amdgcn_mfma_f32_16x16x32_bf16(a0, fb[tt][0], acc, 0, 0, 0);
                acc = __builtin_amdgcn_mfma_f32_16x16x32_bf16(a1, fb[tt][1], acc, 0, 0, 0);
                v2u w; w.x = cvtpk_native(acc[0], acc[1]); w.y = cvtpk_native(acc[2], acc[3]);
                *(LAS v2u*)(Pl + (16 * tt + l15) * 256 + (16 * nt + 4 * quad) * 2) = w;
            }
        }
        asm volatile("s_waitcnt lgkmcnt(0)" ::: "memory");
        float re[64], im[64];
#pragma unroll
        for (int t2 = 0; t2 < 64; ++t2) { const unsigned v = *(const LAS unsigned*)(Pl + t2 * 256 + lane * 4); re[t2] = bf_lo(v); im[t2] = bf_hi(v); }
        fft_dif<64>(re, im);
        __syncthreads();
        int base2 = base; asm volatile("" : "+s"(base2));
#pragma unroll
        for (int i = 0; i < 64; ++i) { const int k2 = brev<64>(i); const f32x2v w = ltw[par * 64 + k2];
            const float yr = re[i] * w.x - im[i] * w.y, yi = re[i] * w.y + im[i] * w.x;
            Y[(size_t)(base2 + t1 * 64 + k2) * 512 + m] = pk2(yr, yi); }
    }
}
template <int N1> __device__ __forceinline__ void f2_fft_part(const Params& P, const int wv_s, int l, int base, int k2, LAS float* red, LAS float* rinv) {
    int tid_ = hw_tid(wv_s); asm volatile("" : "+v"(tid_));
    const int m = tid_, lane = m & 63, wave = __builtin_amdgcn_readfirstlane(m >> 6);
    const unsigned* Y = (const unsigned*)(P.ws + WS_RA);
    bf16* MG = (bf16*)(P.ws + WS_RB + (size_t)M * 1024 * 2);
    unsigned raw[N1]; const unsigned moff = (unsigned)m * 4u;
#pragma unroll
    for (int t1 = 0; t1 < N1; ++t1) raw[t1] = gload_row((const char*)Y + (size_t)(base + t1 * 64 + k2) * 2048, moff);
    asm volatile("s_waitcnt vmcnt(0)" ::: "memory");
    TIE16(raw, 0); TIE16(raw, 16); if constexpr (N1 == 64) { TIE16(raw, 32); TIE16(raw, 48); }
    float re[N1], im[N1];
#pragma unroll
    for (int t1 = 0; t1 < N1; ++t1) { re[t1] = bf_lo(raw[t1]); im[t1] = bf_hi(raw[t1]); }
    fft_dif<N1>(re, im);
#pragma unroll
    for (int i = 0; i < N1; ++i) { const float s = wave_sum_dpp(re[i] * re[i]); if (lane == 0) red[wave * 64 + i] = s; }
    __syncthreads();
    if (m < N1) { float s = 0.f;
#pragma unroll
        for (int w = 0; w < NWAVES; ++w) s += red[w * 64 + m];
        rinv[m] = rsqrtf(s * (1.0f / 512.0f) + EPS); }
    __syncthreads();
    const float g = P.in[12][l * 512 + m];
    int base2 = base; asm volatile("" : "+s"(base2));
#pragma unroll
    for (int i = 0; i < N1; ++i) { const int k1 = brev<N1>(i); const float v = re[i] * rinv[i] * g;
        MG[(size_t)(base2 + 64 * k1 + k2) * 1024 + 512 + m] = (bf16)(pk2(v, 0.f) & 0xffffu); if ((i & 7) == 7) __builtin_amdgcn_sched_barrier(0); }
    __syncthreads();
}
__device__ __forceinline__ void f2_phase(const Params& P, int l, LAS unsigned char* lds, const int wv_s) {
    int tid_ = hw_tid(wv_s); asm volatile("" : "+v"(tid_));
    const int lane = tid_ & 63, wave = __builtin_amdgcn_readfirstlane(tid_ >> 6);
    LAS float* red = (LAS float*)lds; LAS float* rinv = red + 512;
    const bf16* BG = (const bf16*)(P.ws + WS_RB); const bf16* U = BG + (size_t)M * 512;
    bf16* MG = (bf16*)(P.ws + WS_RB + (size_t)M * 1024 * 2);
    for (int item = blockIdx.x; item < 1024 + 512; item += gridDim.x) {
        int base, N1, k2, S;
        if (item < 1024) { base = M_P + (item >> 6) * 4096; k2 = item & 63; N1 = 64; S = 4096; f2_fft_part<64>(P, wv_s, l, base, k2, red, rinv); }
        else { const int it = item - 1024; base = (it >> 6) * 2048; k2 = it & 63; N1 = 32; S = 2048; f2_fft_part<32>(P, wv_s, l, base, k2, red, rinv); }
        f32x4 cw[3][2], cb[2], gc[2];
#pragma unroll
        for (int h = 0; h < 2; ++h) {
#pragma unroll
            for (int t = 0; t < 3; ++t) cw[t][h] = *(const f32x4*)(P.in[9] + (size_t)l * 3 * 512 + t * 512 + 8 * lane + 4 * h);
            cb[h] = *(const f32x4*)(P.in[10] + l * 512 + 8 * lane + 4 * h); gc[h] = *(const f32x4*)(P.in[11] + l * 512 + 8 * lane + 4 * h); }
        for (int kb = 0; kb < N1 / NWAVES; kb += 4) {
            v4u bgv[4], u0[4], um[4], up[4];
#pragma unroll
            for (int q = 0; q < 4; ++q) { const int t = 64 * (wave + NWAVES * (kb + q)) + k2; const size_t row = (size_t)(base + t); const v4u zero = {0u, 0u, 0u, 0u};
                bgv[q] = *(const v4u*)(BG + row * 512 + 8 * lane); u0[q] = *(const v4u*)(U + row * 512 + 8 * lane);
                um[q] = t > 0 ? *(const v4u*)(U + (row - 1) * 512 + 8 * lane) : zero; up[q] = t < S - 1 ? *(const v4u*)(U + (row + 1) * 512 + 8 * lane) : zero; }
#pragma unroll
            for (int q = 0; q < 4; ++q) { const int t = 64 * (wave + NWAVES * (kb + q)) + k2; const size_t row = (size_t)(base + t);
                float co[8]; float ss = 0.f;
#pragma unroll
                for (int e = 0; e < 4; ++e) {
                    const int h = e >> 1, c0 = 2 * (e & 1);
                    const float a0 = cw[0][h][c0] * bf_lo(um[q][e]) + cw[1][h][c0] * bf_lo(u0[q][e]) + cw[2][h][c0] * bf_lo(up[q][e]) + cb[h][c0];
                    const float a1 = cw[0][h][c0 + 1] * bf_hi(um[q][e]) + cw[1][h][c0 + 1] * bf_hi(u0[q][e]) + cw[2][h][c0 + 1] * bf_hi(up[q][e]) + cb[h][c0 + 1];
                    co[2 * e] = bf_lo(bgv[q][e]) * a0; co[2 * e + 1] = bf_hi(bgv[q][e]) * a1; ss += co[2 * e] * co[2 * e] + co[2 * e + 1] * co[2 * e + 1];
                }
                ss = wave_sum_dpp(ss);
                const float ri = rsqrtf(ss * (1.0f / 512.0f) + EPS);
                v4u w;
#pragma unroll
                for (int e = 0; e < 4; ++e) { const int h = e >> 1, c0 = 2 * (e & 1); w[e] = pk2(co[2 * e] * ri * gc[h][c0], co[2 * e + 1] * ri * gc[h][c0 + 1]); }
                *(v4u*)(MG + row * 1024 + 8 * lane) = w; }
        }
    }
}

#ifndef EFUSE
#define EFUSE 1
#endif
__device__ __forceinline__ bool panel_exchange(float part  , const int tid, float* slots, unsigned* cnt, const int pm, const int pn, LAS float* S, const float inv_n) {
    if (tid < 256) {
        __hip_atomic_store(slots + ((size_t)(pm * 256 + tid)) * 4 + pn, part, __ATOMIC_RELAXED, __HIP_MEMORY_SCOPE_AGENT);
        asm volatile("s_waitcnt vmcnt(0)" ::: "memory");
        if ((tid & 63) == 0) __hip_atomic_fetch_add(cnt + 64 * pm, 1u, __ATOMIC_RELAXED, __HIP_MEMORY_SCOPE_AGENT);
    }
    if (tid == 0) { unsigned sp = 0u;
        while (__hip_atomic_load(cnt + 64 * pm, __ATOMIC_RELAXED, __HIP_MEMORY_SCOPE_AGENT) < 16u) { __builtin_amdgcn_s_sleep(1); if (++sp > (1u << 22)) break; } }
    __syncthreads();
    if (tid < 256) { const float* q = slots + ((size_t)(pm * 256 + tid)) * 4;
        const float t = (__hip_atomic_load(q + 0, __ATOMIC_RELAXED, __HIP_MEMORY_SCOPE_AGENT) + __hip_atomic_load(q + 1, __ATOMIC_RELAXED, __HIP_MEMORY_SCOPE_AGENT))
                      + (__hip_atomic_load(q + 2, __ATOMIC_RELAXED, __HIP_MEMORY_SCOPE_AGENT) + __hip_atomic_load(q + 3, __ATOMIC_RELAXED, __HIP_MEMORY_SCOPE_AGENT));
        S[tid] = rsqrtf(t * inv_n + EPS); }
    __syncthreads();
    return true;
}
template <bool DOH, bool LAST, bool FIRST> struct EpiFuse {
    static constexpr bool PERM = true, AFTER_DRAIN = false;
    const Params* P; LAS unsigned char* lds; int wv_s, inst;
    const float *gpost, *modg, *gpre, *modsh, *modsc;
    __device__ __forceinline__ void operator()(const pg8::f32x4 (&acc_c)[2][2][4][2], const pg8::Unit& u, int wr, int wc, int fr, int fq) const {
        typedef pg8::f32x4 (&AccRef)[2][2][4][2];
        AccRef acc = const_cast<AccRef>(acc_c);
        const int ln = fq * 16 + fr, tid = wv_s * 64 + ln;
        LAS float* Pt = (LAS float*)(lds + 131072);
        LAS float* S = (LAS float*)(lds + 131072 + 4096);
        unsigned char* ws = P->ws;
        float* slots = (float*)(ws + WS_SLOT) + (size_t)(2 * inst) * M * 4; unsigned* cnt = (unsigned*)(ws + WS_CNT) + (size_t)(2 * inst) * 320 * 64;
        const int row0 = u.pm * 256 + wr * 64 + fr, cl = u.pn * 256 + wc * 32 + 8 * fq, gbt = row_batch(u.pm * 256);
        bf16* XB = (bf16*)(ws + WS_XB); bf16* RA = (bf16*)(ws + WS_RA);
#pragma unroll
        for (int ai = 0; ai < 2; ++ai)
#pragma unroll
            for (int m = 0; m < 4; ++m) { float sq = 0.f;
#pragma unroll
                for (int bj = 0; bj < 2; ++bj)
#pragma unroll
                    for (int n = 0; n < 2; ++n) { const pg8::f32x4 a = acc[ai][bj][m][n]; sq += (a[0] * a[0] + a[1] * a[1]) + (a[2] * a[2] + a[3] * a[3]); }
                sq += __int_as_float(__builtin_amdgcn_ds_bpermute((ln ^ 16) << 2, __float_as_int(sq))); sq += __int_as_float(__builtin_amdgcn_ds_bpermute((ln ^ 32) << 2, __float_as_int(sq)));
                if (fq == 0) Pt[(ai * 128 + wr * 64 + m * 16 + fr) * 4 + wc] = sq; }
        __syncthreads();
        float part = 0.f;
        if (tid < 256) { const pg8::f32x4 t4 = *(const LAS pg8::f32x4*)(Pt + tid * 4); part = (t4[0] + t4[1]) + (t4[2] + t4[3]); }
        panel_exchange(part, tid, slots, cnt, u.pm, u.pn, S, 1.0f / D);
        pg8::f32x4 gb[2][2];
#pragma unroll
        for (int bj = 0; bj < 2; ++bj)
#pragma unroll
            for (int n = 0; n < 2; ++n) gb[bj][n] = *(const pg8::f32x4*)(modg + (size_t)gbt * 6144 + cl + 128 * bj + 4 * n) * *(const pg8::f32x4*)(gpost + cl + 128 * bj + 4 * n);
        float s2[2][4];
        constexpr int NCH = FIRST ? 4 : 2, MPC = 8 / NCH;
#pragma unroll
        for (int aih = 0; aih < NCH; ++aih) { const int ai = aih / (NCH / 2), mb = (aih % (NCH / 2)) * MPC;
            pg8::u32x4 xb[4][2]; pg8::f32x4 xf[4][2][2];
#pragma unroll
            for (int m = mb; m < mb + MPC; ++m)
#pragma unroll
                for (int bj = 0; bj < 2; ++bj) { const int row = row0 + ai * 128 + m * 16;
                    if (FIRST) { const float* xr = (row < M_P ? P->in[0] + (size_t)row * D : P->in[1] + (size_t)(row - M_P) * D) + cl + 128 * bj; xf[m][bj][0] = *(const pg8::f32x4*)xr; xf[m][bj][1] = *(const pg8::f32x4*)(xr + 4); }
                    else xb[m][bj] = *(const pg8::u32x4*)(XB + (size_t)row * D + cl + 128 * bj); }
#pragma unroll
            for (int m = mb; m < mb + MPC; ++m) { const int row = row0 + ai * 128 + m * 16; const float rinv = S[ai * 128 + wr * 64 + m * 16 + fr]; float sq = 0.f;
#pragma unroll
                for (int bj = 0; bj < 2; ++bj) {
                    pg8::f32x4 x0, x1;
                    if (FIRST) { x0 = xf[m][bj][0]; x1 = xf[m][bj][1]; }
                    else { const pg8::u32x4 w = xb[m][bj]; x0 = (pg8::f32x4){bf_lo(w.x), bf_hi(w.x), bf_lo(w.y), bf_hi(w.y)}; x1 = (pg8::f32x4){bf_lo(w.z), bf_hi(w.z), bf_lo(w.w), bf_hi(w.w)}; }
                    x0 += gb[bj][0] * (acc[ai][bj][m][0] * rinv); x1 += gb[bj][1] * (acc[ai][bj][m][1] * rinv);
                    if (LAST) { float* orow = P->out + (size_t)row * D + cl + 128 * bj; *(pg8::f32x4*)orow = x0; *(pg8::f32x4*)(orow + 4) = x1; }
                    else { pg8::u32x4 w; w.x = cvtpk_native(x0[0], x0[1]); w.y = cvtpk_native(x0[2], x0[3]); w.z = cvtpk_native(x1[0], x1[1]); w.w = cvtpk_native(x1[2], x1[3]);
                        *(pg8::u32x4*)(XB + (size_t)row * D + cl + 128 * bj) = w;
                        x0 = (pg8::f32x4){bf_lo(w.x), bf_hi(w.x), bf_lo(w.y), bf_hi(w.y)}; x1 = (pg8::f32x4){bf_lo(w.z), bf_hi(w.z), bf_lo(w.w), bf_hi(w.w)}; }
                    acc[ai][bj][m][0] = x0; acc[ai][bj][m][1] = x1;
                    sq += ((x0[0] * x0[0] + x0[1] * x0[1]) + (x0[2] * x0[2] + x0[3] * x0[3])) + ((x1[0] * x1[0] + x1[1] * x1[1]) + (x1[2] * x1[2] + x1[3] * x1[3]));
                }
                s2[ai][m] = sq; }
        }
        if (DOH) {
#pragma unroll
            for (int ai = 0; ai < 2; ++ai)
#pragma unroll
                for (int m = 0; m < 4; ++m) { float sq = s2[ai][m];
                    sq += __int_as_float(__builtin_amdgcn_ds_bpermute((ln ^ 16) << 2, __float_as_int(sq))); sq += __int_as_float(__builtin_amdgcn_ds_bpermute((ln ^ 32) << 2, __float_as_int(sq)));
                    if (fq == 0) Pt[(ai * 128 + wr * 64 + m * 16 + fr) * 4 + wc] = sq; }
            __syncthreads();
            float part2 = 0.f;
            if (tid < 256) { const pg8::f32x4 t4 = *(const LAS pg8::f32x4*)(Pt + tid * 4); part2 = (t4[0] + t4[1]) + (t4[2] + t4[3]); }
            panel_exchange(part2, tid, slots + (size_t)M * 4, cnt + 320 * 64, u.pm, u.pn, S, 1.0f / D);
            pg8::f32x4 ga[2][2], sh[2][2];
#pragma unroll
            for (int bj = 0; bj < 2; ++bj)
#pragma unroll
                for (int n = 0; n < 2; ++n) { const int c = cl + 128 * bj + 4 * n;
                    ga[bj][n] = (*(const pg8::f32x4*)(modsc + (size_t)gbt * 6144 + c) + 1.0f) * *(const pg8::f32x4*)(gpre + c); sh[bj][n] = *(const pg8::f32x4*)(modsh + (size_t)gbt * 6144 + c); }
#pragma unroll
            for (int ai = 0; ai < 2; ++ai)
#pragma unroll
                for (int m = 0; m < 4; ++m) { const int row = row0 + ai * 128 + m * 16; const float r2 = S[ai * 128 + wr * 64 + m * 16 + fr];
#pragma unroll
                    for (int bj = 0; bj < 2; ++bj) { const pg8::f32x4 h0 = (acc[ai][bj][m][0] * r2) * ga[bj][0] + sh[bj][0], h1 = (acc[ai][bj][m][1] * r2) * ga[bj][1] + sh[bj][1];
                        pg8::u32x4 w; w.x = cvtpk_native(h0[0], h0[1]); w.y = cvtpk_native(h0[2], h0[3]); w.z = cvtpk_native(h1[0], h1[1]); w.w = cvtpk_native(h1[2], h1[3]);
                        *(pg8::u32x4*)(RA + (size_t)row * D + cl + 128 * bj) = w; } }
        }
        __syncthreads();
    }
};
#define XB_TMO      128
#define XB_XCNT(j)  (256  + 64 * (j))
#define XB_XSUB(j)  (1280 + 64 * (j))
#define XB_XGEN(j)  (2304 + 64 * (j))
#define XB_TOP      3328
#define XB_TOPGEN   3392
#define XCD_BAR_WORDS 3456
#define XB_SPIN_CAP (1u << 18)

__device__ __forceinline__ unsigned xb_ld(unsigned* p)              { return __hip_atomic_load(p, __ATOMIC_RELAXED, __HIP_MEMORY_SCOPE_AGENT); }
__device__ __forceinline__ unsigned xb_add(unsigned* p, unsigned v) { return __hip_atomic_fetch_add(p, v, __ATOMIC_RELAXED, __HIP_MEMORY_SCOPE_AGENT); }
__device__ __forceinline__ unsigned xb_xcc_id() { return (unsigned)__builtin_amdgcn_s_getreg((3 << 11) | 20) & 0xFu; }
#define XB_SPIN(cond, bar) do { unsigned _sp = 0; while (cond) { __builtin_amdgcn_s_sleep(1); \
    if ((++_sp & 255u) == 0u) { if (xb_ld(&(bar)[XB_TMO])) break; if (_sp > XB_SPIN_CAP) { atomicAdd(&(bar)[XB_TMO], 1u); break; } } } } while (0)

struct XcdBarrier {
    unsigned* bar; unsigned x;
    volatile LAS unsigned* st;
};

__device__ __forceinline__ XcdBarrier xcd_barrier_post(unsigned* bar, volatile LAS unsigned* st) {
    XcdBarrier b; b.bar = bar; b.x = xb_xcc_id(); b.st = st;
    if (threadIdx.x == 0) (void)xb_add(&bar[XB_XCNT(b.x)], 1u);
    return b;
}
__device__ __forceinline__ void xcd_barrier_complete(unsigned* bar, unsigned x, unsigned& nloc, unsigned& nx) {
    const unsigned G = gridDim.x * gridDim.y * gridDim.z;
    unsigned sum, cnt, mine, sp = 0u;
    for (;;) {
        sum = 0u; cnt = 0u; mine = 0u;
#pragma unroll
        for (unsigned j = 0; j < 16; ++j) { const unsigned c = xb_ld(&bar[XB_XCNT(j)]); sum += c; cnt += (c > 0u) ? 1u : 0u; mine = (j == x) ? c : mine; }
        if (sum == G) break;
        __builtin_amdgcn_s_sleep(1);
        if ((++sp & 255u) == 0u) { if (xb_ld(&bar[XB_TMO])) break; if (sp > XB_SPIN_CAP) { atomicAdd(&bar[XB_TMO], 1u); break; } }
    }
    nloc = mine > 0u ? mine : 1u; nx = cnt > 0u ? cnt : 1u;
}

__device__ __forceinline__ void xcd_barrier(const XcdBarrier& b) {
    asm volatile("s_waitcnt vmcnt(0)" ::: "memory");
    __syncthreads();
    if (threadIdx.x == 0) {
        unsigned* bar = b.bar;
        __builtin_amdgcn_s_waitcnt(0);
        unsigned nloc = b.st[0], nx = b.st[1];
        if (nloc == 0u) { xcd_barrier_complete(bar, b.x, nloc, nx); b.st[0] = nloc; b.st[1] = nx; }
        const unsigned old = xb_add(&bar[XB_XSUB(b.x)], 1u);
        const unsigned gen = old / nloc;
        if (old + 1u == (gen + 1u) * nloc) {
            __builtin_amdgcn_fence(__ATOMIC_RELEASE, "agent");
            asm volatile("s_waitcnt vmcnt(0)" ::: "memory");
            const unsigned og = xb_add(&bar[XB_TOP], 1u);
            const unsigned tg = og / nx;
            if (og + 1u == (tg + 1u) * nx) xb_add(&bar[XB_TOPGEN], 1u);
            else XB_SPIN(xb_ld(&bar[XB_TOPGEN]) == tg, bar);
            __builtin_amdgcn_fence(__ATOMIC_ACQUIRE, "agent");
            xb_add(&bar[XB_XGEN(b.x)], 1u);
            asm volatile("s_waitcnt vmcnt(0)" ::: "memory");
        } else {
            XB_SPIN(xb_ld(&bar[XB_XGEN(b.x)]) == gen, bar);
            __builtin_amdgcn_fence(__ATOMIC_ACQUIRE, "agent");
            asm volatile("s_waitcnt vmcnt(0)" ::: "memory");
        }
    }
    __syncthreads();
}

#ifndef REP_P0
#define REP_P0 0
#endif
#ifndef REP_SYNC
#define REP_SYNC 0
#endif
#ifndef REP_N0
#define REP_N0 0
#endif
#ifndef RFUSE
#define RFUSE 0
#endif
#ifndef REPMASK
#define REPMASK 0
#endif
#ifndef PHM
#define PHM 0xffff
#endif
constexpr int N_PHASES = 2 + 8 * DEPTH;
__global__ void __launch_bounds__(NTHREADS, 2) fwd_kernel(Params P) {
    extern __shared__ __attribute__((aligned(16))) unsigned char lds_raw[];
    LAS unsigned char* lds = (LAS unsigned char*)lds_raw;
    const int wv_s = __builtin_amdgcn_readfirstlane(threadIdx.x >> 6);
    unsigned char* ws = P.ws;
    const float* mod = (const float*)(ws + WS_MOD);
    bf16* RA = (bf16*)(ws + WS_RA); bf16* RB = (bf16*)(ws + WS_RB);
    float* stats = (float*)(ws + WS_STATS);
    volatile LAS unsigned* bst = (volatile LAS unsigned*)(lds + MISC_OFF + 512);
    if (threadIdx.x == 0) { bst[0] = 0u; bst[1] = 0u; }
    __syncthreads();
    XcdBarrier bar; bar.bar = (unsigned*)(ws + WS_BAR); bar.x = 0; bar.st = bst;
    for (int ph = P.ph_lo; ph < P.ph_hi; ++ph) {
        if (ph == 0) p0_prep(P, lds, wv_s);
        else if (ph == 1) { p0_weights(P, lds, wv_s); row_phase<false, true, false, true>(P, wv_s, nullptr, nullptr, P.in[6], mod + 0 * D, mod + 1 * D); }
        else {
            const int l = (ph - 2) >> 3, s = (ph - 2) & 7;
            const float* modl = mod + (size_t)l * NB * 6144;
            const bool fuse = EFUSE && XBF16 && gridDim.x == 256;
            if (fuse && (s == 4 || s == 7)) continue;
            if (s == 0) { pg8::Gemm g{RA, (const bf16*)(ws + WS_WIN) + (size_t)l * N_IN * D, M, N_IN, D}; pg8::StaticOrder S; S.init(M, N_IN, gridDim.x, blockIdx.x);
                pg8::EpiIn E{RB, RB + (size_t)M * 512, RB + (size_t)M * 1024};
                pg8::gemm_phase<pg8::EpiIn, pg8::StaticOrder, true, true>(lds, g, S, E, wv_s); }
            else if (s == 1) f1_phase(P, lds, wv_s);
            else if (s == 2) f2_phase(P, l, lds, wv_s);
            else if (s == 3) { pg8::Gemm g{RB + (size_t)M * 1024, (const bf16*)(ws + WS_WOUT) + (size_t)l * D * D, M, D, D}; pg8::StaticOrder S; S.init(M, D, gridDim.x, blockIdx.x);
                if (fuse) {
                    if (l == 0) { EpiFuse<true, false, true> E{&P, lds, wv_s, 2 * l, P.in[7] + l * D, modl + 2 * D, P.in[14] + l * D, modl + 3 * D, modl + 4 * D};
                        pg8::gemm_phase<EpiFuse<true, false, true>, pg8::StaticOrder, true, true>(lds, g, S, E, wv_s); }
                    else { EpiFuse<true, false, false> E{&P, lds, wv_s, 2 * l, P.in[7] + l * D, modl + 2 * D, P.in[14] + l * D, modl + 3 * D, modl + 4 * D};
                        pg8::gemm_phase<EpiFuse<true, false, false>, pg8::StaticOrder, true, true>(lds, g, S, E, wv_s); } }
                else { pg8::EpiOS E{RA, stats};
                pg8::gemm_phase<pg8::EpiOS, pg8::StaticOrder, true, true>(lds, g, S, E, wv_s); } }
            else if (s == 4) { if (l == 0) row_phase<true, true, false, true>(P, wv_s, P.in[7] + l * D, modl + 2 * D, P.in[14] + l * D, modl + 3 * D, modl + 4 * D);
                               else row_phase<true, true, false, false>(P, wv_s, P.in[7] + l * D, modl + 2 * D, P.in[14] + l * D, modl + 3 * D, modl + 4 * D); }
            else if (s == 5) { pg8::Gemm g{RA, (const bf16*)(ws + WS_WGU) + (size_t)l * N_GU * D, M, N_GU, D}; pg8::StaticOrder S; S.init(M, N_GU, gridDim.x, blockIdx.x);
                pg8::EpiAct E{RB};
                pg8::gemm_phase<pg8::EpiAct, pg8::StaticOrder, true, true>(lds, g, S, E, wv_s); }
            else if (s == 6) { pg8::Gemm g{RB, (const bf16*)(ws + WS_WDN) + (size_t)l * D * DFF, M, D, DFF}; pg8::StaticOrder S; S.init(M, D, gridDim.x, blockIdx.x);
                if (fuse) {
                    if (l < DEPTH - 1) { EpiFuse<true, false, false> E{&P, lds, wv_s, 2 * l + 1, P.in[15] + l * D, modl + 5 * D, P.in[6] + (l + 1) * D, modl + NB * 6144 + 0 * D, modl + NB * 6144 + 1 * D};
                        pg8::gemm_phase<EpiFuse<true, false, false>, pg8::StaticOrder, true, true>(lds, g, S, E, wv_s); }
                    else { EpiFuse<false, true, false> E{&P, lds, wv_s, 2 * l + 1, P.in[15] + l * D, modl + 5 * D, nullptr, nullptr, nullptr};
                        pg8::gemm_phase<EpiFuse<false, true, false>, pg8::StaticOrder, true, true>(lds, g, S, E, wv_s); } }
                else { pg8::EpiOS E{RA, stats};
                pg8::gemm_phase<pg8::EpiOS, pg8::StaticOrder, true, true>(lds, g, S, E, wv_s); } }
            else { if (l < DEPTH - 1) row_phase<true, true, false, false>(P, wv_s, P.in[15] + l * D, modl + 5 * D, P.in[6] + (l + 1) * D, modl + NB * 6144 + 0 * D, modl + NB * 6144 + 1 * D);
                   else row_phase<true, false, true, false>(P, wv_s, P.in[15] + l * D, modl + 5 * D, nullptr, nullptr, nullptr); }
        }
        if (ph + 1 < P.ph_hi) {
            if (ph == 0) { __syncthreads(); cg::this_grid().sync(); bar = xcd_barrier_post((unsigned*)(ws + WS_BAR), bst); }
            else xcd_barrier(bar);
        }
    }
}

extern "C" void kernel_launch(void* const* d_in, const int* in_sizes, int n_in, void* d_out, int out_size, void* d_ws, size_t ws_size, hipStream_t stream) {
    static int grid = 0;
    if (!grid) {
        int dev = 0, cus = 0, per_cu = 0;
        hipGetDevice(&dev); hipDeviceGetAttribute(&cus, hipDeviceAttributeMultiprocessorCount, dev);
        if (hipFuncSetAttribute((const void*)fwd_kernel, hipFuncAttributeMaxDynamicSharedMemorySize, LDS_BYTES) != hipSuccess) fprintf(stderr, "kernel_launch: hipFuncSetAttribute failed\n");
        if (hipOccupancyMaxActiveBlocksPerMultiprocessor(&per_cu, (const void*)fwd_kernel, NTHREADS, LDS_BYTES) != hipSuccess || per_cu < 1) { fprintf(stderr, "kernel_launch: occupancy query says %d\n", per_cu); per_cu = 1; }
        grid = cus > 0 ? cus : 256;
        if (n_in != 19 || ws_size < WS_END) fprintf(stderr, "kernel_launch: unexpected n_in %d / ws_size %zu (need %zu)\n", n_in, ws_size, (size_t)WS_END);
    }
    Params p{};
    for (int i = 0; i < 19; ++i) p.in[i] = (const float*)d_in[i];
    p.out = (float*)d_out; p.ws = (unsigned char*)d_ws;
#if MK_ONE_LAUNCH
    p.ph_lo = 0; p.ph_hi = N_PHASES;
    void* args[] = {&p};
    hipError_t e = hipLaunchCooperativeKernel((const void*)fwd_kernel, dim3(grid), dim3(NTHREADS), args, LDS_BYTES, stream);
    if (e != hipSuccess) fprintf(stderr, "kernel_launch: cooperative launch failed: %s (grid %d)\n", hipGetErrorString(e), grid);
#else
    for (int ph = 0; ph < N_PHASES; ++ph) { p.ph_lo = ph; p.ph_hi = ph + 1; hipLaunchKernelGGL(fwd_kernel, dim3(grid), dim3(NTHREADS), LDS_BYTES, stream, p); }
#endif
}
```

```cpp
#include <hip/hip_runtime.h>
#include <hip/hip_cooperative_groups.h>
#include <cstdio>
#include <cstdint>
namespace cg = cooperative_groups;
#ifndef MK_ONE_LAUNCH
#define MK_ONE_LAUNCH 1
#endif
namespace pg8 {
#define PG8_LAS __attribute__((address_space(3)))
typedef unsigned short bf16_t;
typedef short bf16x8 __attribute__((ext_vector_type(8)));
typedef float f32x4 __attribute__((ext_vector_type(4)));
typedef unsigned u32x4 __attribute__((ext_vector_type(4)));
constexpr int BM = 256, BK = 64, HALF = 128, HTB = HALF * BK * 2  , STAGE_BYTES = 8 * HTB, NXCD = 8, WGM = 8;

__host__ __device__ __forceinline__ int lds_byte(int r, int c) { const int st = (r >> 4) * 2 + (c >> 5), rr = r & 15, cc = c & 31, ob = rr * 64 + cc * 2; return st * 1024 + (ob ^ (((ob >> 9) & 1) << 5)); }
__host__ __device__ __forceinline__ void stage_rc(int b, int& R, int& C) { const int st = b / 1024, sb = b % 1024, swz = sb ^ (((sb >> 9) & 1) << 5); R = (st >> 1) * 16 + swz / 64; C = (st & 1) * 32 + (swz % 64) / 2; }
__host__ __device__ __forceinline__ int perm32(int rho) { const int n = rho >> 4, i = rho & 15; return 8 * (i >> 2) + 4 * n + (i & 3); }

struct Unit { int pm, pn; };
struct Gemm { const bf16_t* A; const bf16_t* Bt; int M, N, K; };

struct StaticOrder {
    int nM, nN, nwg, G, c;
    __host__ __device__ void init(int M, int N, int G_, int c_) { nM = M / BM; nN = N / BM; nwg = nM * nN; G = G_; c = c_; }
    __host__ __device__ bool next(int i, Unit& u) const {
        const long L = (long)i * G + c; if (L >= nwg) return false;
        int wgid = (int)L; { const int q = nwg / NXCD, r = nwg % NXCD, xcd = wgid % NXCD, off = wgid / NXCD; wgid = (xcd < r ? xcd * (q + 1) : r * (q + 1) + (xcd - r) * q) + off; }
        const int nig = WGM * nN, gid = wgid / nig, fm = gid * WGM, gsz = (nM - fm) < WGM ? (nM - fm) : WGM;
        u.pm = fm + ((wgid % nig) % gsz); u.pn = (wgid % nig) / gsz; return true;
    }
    __device__ __forceinline__ void a_ready(const Unit&) const {}
    __device__ __forceinline__ void done(const Unit&) const {}
};
__device__ __forceinline__ unsigned cvt_pk_bf16(float lo, float hi) { unsigned r; asm volatile("v_cvt_pk_bf16_f32 %0, %1, %2" : "=v"(r) : "v"(lo), "v"(hi)); return r; }
typedef float f32x2c_t __attribute__((ext_vector_type(2))); typedef __bf16 bf16x2c_t __attribute__((ext_vector_type(2)));
__device__ __forceinline__ unsigned cvt_pk_native(float lo, float hi) { const f32x2c_t v = {lo, hi}; const bf16x2c_t b = __builtin_convertvector(v, bf16x2c_t); return __builtin_bit_cast(unsigned, b); }
__device__ __forceinline__ u32x4 pack8(const f32x4 v0, const f32x4 v1) { u32x4 w; w.x = cvt_pk_native(v0[0], v0[1]); w.y = cvt_pk_native(v0[2], v0[3]); w.z = cvt_pk_native(v1[0], v1[1]); w.w = cvt_pk_native(v1[2], v1[3]); return w; }
struct EpiIn {
    static constexpr bool PERM = true, AFTER_DRAIN = false;
    bf16_t *BG, *U, *ZF;
    __device__ __forceinline__ void operator()(const f32x4 (&acc)[2][2][4][2], const Unit& u, int wr, int wc, int fr, int fq) const {
        const int row0 = u.pm * BM + wr * 64 + fr, cl = wc * 32 + 8 * fq;
        if (u.pn < 2) {
#pragma unroll
            for (int ai = 0; ai < 2; ++ai)
#pragma unroll
                for (int m = 0; m < 4; ++m) { bf16_t* rowp = BG + (size_t)(row0 + ai * HALF + m * 16) * 512 + u.pn * 256 + cl;
#pragma unroll
                    for (int bj = 0; bj < 2; ++bj) *(u32x4*)(rowp + bj * HALF) = pack8(acc[ai][bj][m][0], acc[ai][bj][m][1]); }
        } else if (u.pn < 6) {
#pragma unroll
            for (int ai = 0; ai < 2; ++ai)
#pragma unroll
                for (int m = 0; m < 4; ++m) { bf16_t* rowp = U + (size_t)(row0 + ai * HALF + m * 16) * 512 + (u.pn - 2) * 128 + cl;
                    *(u32x4*)rowp = pack8(acc[ai][0][m][0] * acc[ai][1][m][0], acc[ai][0][m][1] * acc[ai][1][m][1]); }
        } else {
#pragma unroll
            for (int ai = 0; ai < 2; ++ai)
#pragma unroll
                for (int m = 0; m < 4; ++m) { bf16_t* rowp = ZF + (size_t)(row0 + ai * HALF + m * 16) * 512 + (u.pn - 6) * 256 + cl;
#pragma unroll
                    for (int bj = 0; bj < 2; ++bj) *(u32x4*)(rowp + bj * HALF) = pack8(acc[ai][bj][m][0], acc[ai][bj][m][1]); }
        }
    }
};
struct EpiOS {
    static constexpr bool PERM = true, AFTER_DRAIN = false;
    bf16_t* O; float* stats;
    __device__ __forceinline__ void operator()(const f32x4 (&acc)[2][2][4][2], const Unit& u, int wr, int wc, int fr, int fq) const {
        const int row0 = u.pm * BM + wr * 64 + fr, cl = wc * 32 + 8 * fq;
#pragma unroll
        for (int ai = 0; ai < 2; ++ai)
#pragma unroll
            for (int m = 0; m < 4; ++m) { const int row = row0 + ai * HALF + m * 16; bf16_t* rowp = O + (size_t)row * 1024 + u.pn * 256 + cl; float s = 0.f;
#pragma unroll
                for (int bj = 0; bj < 2; ++bj) { const f32x4 a = acc[ai][bj][m][0], b = acc[ai][bj][m][1];
                    s += (a[0] * a[0] + a[1] * a[1]) + (a[2] * a[2] + a[3] * a[3]) + (b[0] * b[0] + b[1] * b[1]) + (b[2] * b[2] + b[3] * b[3]);
                    *(u32x4*)(rowp + bj * HALF) = pack8(a, b); }
                { const int ln = fq * 16 + fr;
                  s += __int_as_float(__builtin_amdgcn_ds_bpermute((ln ^ 16) << 2, __float_as_int(s))); s += __int_as_float(__builtin_amdgcn_ds_bpermute((ln ^ 32) << 2, __float_as_int(s))); }
                if (fq == 0) stats[(size_t)row * 16 + u.pn * 4 + wc] = s; }
    }
};
__device__ __forceinline__ float silu_f(float g) { return g * __builtin_amdgcn_rcpf(1.0f + __expf(-g)); }
typedef float f32x2e __attribute__((ext_vector_type(2)));
__device__ __forceinline__ f32x2e silu_mul2(f32x2e g, f32x2e u) {
    f32x2e t = g * (-1.4426950408889634f);
    t.x = __builtin_fminf(t.x, 60.0f); t.y = __builtin_fminf(t.y, 60.0f);
    f32x2e p; p.x = __builtin_amdgcn_exp2f(t.x); p.y = __builtin_amdgcn_exp2f(t.y);
    p = p + 1.0f;
    const float r = __builtin_amdgcn_rcpf(p.x * p.y);
    const f32x2e sw = {p.y, p.x};
    return (g * u) * (sw * r);
}
__device__ __forceinline__ f32x4 silu_mul4(const f32x4 g, const f32x4 u) {
    const f32x2e a = silu_mul2((f32x2e){g[0], g[1]}, (f32x2e){u[0], u[1]}), b = silu_mul2((f32x2e){g[2], g[3]}, (f32x2e){u[2], u[3]});
    return (f32x4){a.x, a.y, b.x, b.y};
}
struct EpiAct {
    static constexpr bool PERM = true, AFTER_DRAIN = false;
    bf16_t* ACT;
    __device__ __forceinline__ void operator()(const f32x4 (&acc)[2][2][4][2], const Unit& u, int wr, int wc, int fr, int fq) const {
        const int row0 = u.pm * BM + wr * 64 + fr, cl = wc * 32 + 8 * fq;
#pragma unroll
        for (int ai = 0; ai < 2; ++ai)
#pragma unroll
            for (int m = 0; m < 4; ++m) { bf16_t* rowp = ACT + (size_t)(row0 + ai * HALF + m * 16) * 2816 + u.pn * 128 + cl;
                const f32x4 v0 = silu_mul4(acc[ai][0][m][0], acc[ai][1][m][0]), v1 = silu_mul4(acc[ai][0][m][1], acc[ai][1][m][1]);
                *(u32x4*)rowp = pack8(v0, v1); }
    }
};
struct EpiNull {
    static constexpr bool PERM = true, AFTER_DRAIN = false;
    float* dummy;
    __device__ __forceinline__ void operator()(const f32x4 (&acc)[2][2][4][2], const Unit& u, int wr, int wc, int fr, int fq) const {
        float s = 0.f;
#pragma unroll
        for (int ai = 0; ai < 2; ++ai)
#pragma unroll
            for (int bj = 0; bj < 2; ++bj)
#pragma unroll
                for (int m = 0; m < 4; ++m)
#pragma unroll
                    for (int n = 0; n < 2; ++n) s += (acc[ai][bj][m][n][0] + acc[ai][bj][m][n][1]) + (acc[ai][bj][m][n][2] + acc[ai][bj][m][n][3]);
        if (s == 1.2345678e33f) dummy[u.pm * 256 + fr] = s;
    }
};
template <class Epi, class Sched, bool ALIGN_EPI = false, bool SP2 = false>
__device__ __forceinline__ void gemm_phase(PG8_LAS unsigned char* lds, const Gemm g, const Sched& S, const Epi& E, const int wv_s) {
    int tid_; asm volatile("v_mbcnt_lo_u32_b32 %0, -1, 0\n\tv_mbcnt_hi_u32_b32 %0, -1, %0" : "=v"(tid_)); tid_ += wv_s * 64;
    const int tid = tid_, wid = __builtin_amdgcn_readfirstlane(tid >> 6), lane = tid & 63, wr = wid >> 2, wc = wid & 3, fr = lane & 15, fq = lane >> 4;
    const int K = g.K, nt = K / BK;
    unsigned voffA[2], voffB[2];
#pragma unroll
    for (int i = 0; i < 2; ++i) { int R, C; stage_rc(tid * 16 + i * 8192, R, C); const int Rb = Epi::PERM ? ((R & ~31) + perm32(R & 31)) : R;
        voffA[i] = (unsigned)(R * K + C) * 2u; voffB[i] = (unsigned)(Rb * K + C) * 2u; }
    const size_t kstep = (size_t)(BK * 2);
    const size_t hstep = (size_t)HALF * K * 2;
    const size_t tstep = 2 * hstep;
    const unsigned ldsw = (unsigned)wid * 1024u;
    const int aoff = lds_byte(wr * 64 + fr, fq * 8), boff = lds_byte(wc * 32 + fr, fq * 8);
#define PG8_SA(b, h) (((b) * 2 + (h)) * HTB)
#define PG8_SB(b, h) ((4 + (b) * 2 + (h)) * HTB)
#define PG8_STAGE(bufoff, gbase, voff) do { _Pragma("unroll") for (int _i = 0; _i < 2; ++_i) \
        __builtin_amdgcn_global_load_lds((const unsigned*)((const char*)(gbase) + (voff)[_i]), (PG8_LAS unsigned*)(lds + (bufoff) + ldsw + _i * 8192), 16, 0, 0); } while (0)
#define PG8_LDA(dst, b, h) do { _Pragma("unroll") for (int m = 0; m < 4; ++m) _Pragma("unroll") for (int k = 0; k < 2; ++k) dst[m][k] = *(const PG8_LAS bf16x8*)(lds + PG8_SA(b, h) + aoff + m * 2048 + k * 1024); } while (0)
#define PG8_LDB(dst, b, h) do { _Pragma("unroll") for (int n = 0; n < 2; ++n) _Pragma("unroll") for (int k = 0; k < 2; ++k) dst[n][k] = *(const PG8_LAS bf16x8*)(lds + PG8_SB(b, h) + boff + n * 2048 + k * 1024); } while (0)
#define PG8_MMA(ai, bj, At, Bt) do { __builtin_amdgcn_s_setprio(1); _Pragma("unroll") for (int m = 0; m < 4; ++m) _Pragma("unroll") for (int n = 0; n < 2; ++n) _Pragma("unroll") for (int k = 0; k < 2; ++k) \
        acc[ai][bj][m][n] = __builtin_amdgcn_mfma_f32_16x16x32_bf16(Bt[n][k], At[m][k], acc[ai][bj][m][n], 0, 0, 0); __builtin_amdgcn_s_setprio(0); } while (0)
#define PG8_WAIT_V(n) asm volatile("s_waitcnt vmcnt(" #n ")" ::: "memory")
#define PG8_WAIT_L(n) asm volatile("s_waitcnt lgkmcnt(" #n ")" ::: "memory")
#define PG8_BAR __builtin_amdgcn_s_barrier()
#define PG8_SCHED __builtin_amdgcn_sched_barrier(0)
    Unit cur, nxt; int ui = 0;
    if (!S.next(0, cur)) return;
    f32x4 acc[2][2][4][2];
#pragma unroll
    for (int a = 0; a < 2; ++a)
#pragma unroll
        for (int b = 0; b < 2; ++b)
#pragma unroll
            for (int m = 0; m < 4; ++m)
#pragma unroll
                for (int n = 0; n < 2; ++n) acc[a][b][m][n] = (f32x4){0.f, 0.f, 0.f, 0.f};
    bf16x8 At[4][2], B0[2][2], B1[2][2];
    const char* cA = (const char*)g.A + (size_t)cur.pm * tstep; const char* cB = (const char*)g.Bt + (size_t)cur.pn * tstep;
    S.a_ready(cur);
    if constexpr (SP2) {
        PG8_STAGE(PG8_SB(0, 0), cB, voffB); PG8_STAGE(PG8_SB(0, 1), cB + hstep, voffB); PG8_STAGE(PG8_SA(0, 0), cA, voffA); PG8_STAGE(PG8_SA(0, 1), cA + hstep, voffA);
        if (wr == 1) PG8_BAR;
        PG8_WAIT_V(2); PG8_BAR;
        PG8_STAGE(PG8_SB(1, 0), cB + kstep, voffB); PG8_STAGE(PG8_SA(1, 0), cA + kstep, voffA); PG8_STAGE(PG8_SB(1, 1), cB + hstep + kstep, voffB);
        PG8_WAIT_V(6); PG8_BAR;
    } else {
        PG8_STAGE(PG8_SB(0, 0), cB, voffB); PG8_STAGE(PG8_SA(0, 0), cA, voffA); PG8_STAGE(PG8_SB(0, 1), cB + hstep, voffB); PG8_STAGE(PG8_SA(0, 1), cA + hstep, voffA);
        if (wr == 1) PG8_BAR;
        PG8_WAIT_V(4); PG8_BAR;
        PG8_STAGE(PG8_SB(1, 0), cB + kstep, voffB); PG8_STAGE(PG8_SA(1, 0), cA + kstep, voffA); PG8_STAGE(PG8_SB(1, 1), cB + hstep + kstep, voffB);
        PG8_WAIT_V(6); PG8_BAR;
    }
    for (;;) {
        const bool has_next = S.next(ui + 1, nxt);
        const char* nA = has_next ? (const char*)g.A + (size_t)nxt.pm * tstep : cA; const char* nB = has_next ? (const char*)g.Bt + (size_t)nxt.pn * tstep : cB;
        for (int t = 0; t < nt; t += 2) {
            const bool last = (t == nt - 2);
            const char* a1 = cA + (size_t)(t + 1) * kstep;
            const char* a2 = last ? nA : cA + (size_t)(t + 2) * kstep; const char* b2 = last ? nB : cB + (size_t)(t + 2) * kstep;
            const char* a3 = a2 + kstep; const char* b3 = b2 + kstep;
            if (last && has_next) S.a_ready(nxt);
            if constexpr (SP2) {
            PG8_LDB(B0, 0, 0); PG8_LDB(B1, 0, 1); PG8_SCHED; PG8_LDA(At, 0, 0); PG8_STAGE(PG8_SA(1, 1), a1 + hstep, voffA);
            PG8_WAIT_V(8); PG8_WAIT_L(0); PG8_BAR; PG8_MMA(0, 0, At, B0); PG8_MMA(0, 1, At, B1); PG8_BAR; PG8_SCHED;
            PG8_LDA(At, 0, 1); PG8_STAGE(PG8_SB(0, 0), b2, voffB); PG8_STAGE(PG8_SB(0, 1), b2 + hstep, voffB); PG8_STAGE(PG8_SA(0, 0), a2, voffA);
            PG8_WAIT_V(8); PG8_WAIT_L(0); PG8_BAR; PG8_MMA(1, 0, At, B0); PG8_MMA(1, 1, At, B1); PG8_BAR; PG8_SCHED;
            PG8_LDB(B0, 1, 0); PG8_LDB(B1, 1, 1); PG8_SCHED; PG8_LDA(At, 1, 0); PG8_STAGE(PG8_SA(0, 1), a2 + hstep, voffA);
            PG8_WAIT_V(8); PG8_WAIT_L(0); PG8_BAR; PG8_MMA(0, 0, At, B0); PG8_MMA(0, 1, At, B1); PG8_BAR; PG8_SCHED;
            PG8_LDA(At, 1, 1); PG8_STAGE(PG8_SB(1, 0), b3, voffB); PG8_STAGE(PG8_SB(1, 1), b3 + hstep, voffB); PG8_STAGE(PG8_SA(1, 0), a3, voffA);
            PG8_WAIT_V(8); PG8_WAIT_L(0); PG8_BAR; PG8_MMA(1, 0, At, B0); PG8_MMA(1, 1, At, B1); PG8_BAR; PG8_SCHED;
            } else {
            PG8_LDB(B0, 0, 0); PG8_SCHED; PG8_LDA(At, 0, 0); PG8_STAGE(PG8_SA(1, 1), a1 + hstep, voffA);
            PG8_WAIT_L(8); PG8_BAR; PG8_WAIT_L(0); PG8_MMA(0, 0, At, B0); PG8_BAR; PG8_SCHED;
            PG8_LDB(B1, 0, 1); PG8_STAGE(PG8_SB(0, 0), b2, voffB);
            PG8_BAR; PG8_WAIT_L(0); PG8_MMA(0, 1, At, B1); PG8_BAR;
            PG8_LDA(At, 0, 1); PG8_STAGE(PG8_SA(0, 0), a2, voffA);
            PG8_BAR; PG8_WAIT_L(0); PG8_MMA(1, 0, At, B0); PG8_BAR; PG8_SCHED;
            PG8_STAGE(PG8_SB(0, 1), b2 + hstep, voffB);
            PG8_WAIT_V(6); PG8_BAR; PG8_MMA(1, 1, At, B1); PG8_BAR;
            PG8_LDB(B0, 1, 0); PG8_SCHED; PG8_LDA(At, 1, 0); PG8_STAGE(PG8_SA(0, 1), a2 + hstep, voffA);
            PG8_WAIT_L(8); PG8_BAR; PG8_WAIT_L(0); PG8_MMA(0, 0, At, B0); PG8_BAR; PG8_SCHED;
            PG8_LDB(B1, 1, 1); PG8_STAGE(PG8_SB(1, 0), b3, voffB);
            PG8_BAR; PG8_WAIT_L(0); PG8_MMA(0, 1, At, B1); PG8_BAR;
            PG8_LDA(At, 1, 1); PG8_STAGE(PG8_SA(1, 0), a3, voffA);
            PG8_BAR; PG8_WAIT_L(0); PG8_MMA(1, 0, At, B0); PG8_BAR; PG8_SCHED;
            PG8_STAGE(PG8_SB(1, 1), b3 + hstep, voffB);
            PG8_WAIT_V(6); PG8_BAR; PG8_MMA(1, 1, At, B1); PG8_BAR;
            }
        }
        if constexpr (ALIGN_EPI) { if (wr == 0) PG8_BAR; }
        if constexpr (!Epi::AFTER_DRAIN) { E(acc, cur, wr, wc, fr, fq); S.done(cur); }
        if (!has_next) break;
#pragma unroll
        for (int a = 0; a < 2; ++a)
#pragma unroll
            for (int b = 0; b < 2; ++b)
#pragma unroll
                for (int m = 0; m < 4; ++m)
#pragma unroll
                    for (int n = 0; n < 2; ++n) acc[a][b][m][n] = (f32x4){0.f, 0.f, 0.f, 0.f};
        cur = nxt; cA = nA; cB = nB; ++ui;
        if constexpr (ALIGN_EPI) { if (wr == 1) PG8_BAR; }
    }
    PG8_WAIT_V(0);
    if constexpr (!ALIGN_EPI) { if (wr == 0) PG8_BAR; }
    PG8_BAR;
    if constexpr (Epi::AFTER_DRAIN) { E.fused(acc, cur, wr, wc, fr, fq, lds, wid, lane); S.done(cur); }
#undef PG8_SA
#undef PG8_SB
#undef PG8_STAGE
#undef PG8_LDA
#undef PG8_LDB
#undef PG8_MMA
#undef PG8_WAIT_V
#undef PG8_WAIT_L
#undef PG8_BAR
#undef PG8_SCHED
}
}
#define LAS __attribute__((address_space(3)))
typedef unsigned short bf16;
typedef float f32x4 __attribute__((ext_vector_type(4)));
typedef unsigned v4u __attribute__((ext_vector_type(4)));
typedef unsigned v2u __attribute__((ext_vector_type(2)));
constexpr int D = 1024, M_P = 16384, M_S = 65536, M = M_P + M_S, NB = 24, DEPTH = 4;
constexpr int N_IN = 2048, N_GU = 5632, DFF = 2816;
constexpr float EPS = 1e-6f;
constexpr int NWAVES = 8, NTHREADS = 512;
constexpr int LDS_BYTES = 147456 + 2048;
constexpr int MISC_OFF = 147456;
constexpr size_t WS_WIN = 0;
constexpr size_t WS_WOUT = WS_WIN + (size_t)DEPTH * N_IN * D * 2;
constexpr size_t WS_WGU = WS_WOUT + (size_t)DEPTH * D * D * 2;
constexpr size_t WS_WDN = WS_WGU + (size_t)DEPTH * N_GU * D * 2;
constexpr size_t WS_MOD = WS_WDN + (size_t)DEPTH * D * DFF * 2;
constexpr size_t WS_TW4 = WS_MOD + (size_t)DEPTH * NB * 6 * D * 4;
constexpr size_t WS_TW2 = WS_TW4 + 4096 * 8;
constexpr size_t WS_STATS = WS_TW2 + 2048 * 8;
constexpr size_t WS_RA = WS_STATS + (size_t)M * 16 * 4;
constexpr size_t WS_RB = WS_RA + (size_t)M * D * 2;
constexpr size_t WS_BAR = WS_RB + (size_t)M * DFF * 2 + (size_t)M * D * 2;
constexpr size_t WS_XB = WS_RB + (size_t)M * DFF * 2;
constexpr size_t WS_CNT = WS_BAR + 16384;
constexpr size_t WS_SLOT = WS_CNT + (size_t)16 * 320 * 256;
constexpr size_t WS_END = WS_SLOT + (size_t)16 * M * 4 * 4;
constexpr float C64[64] = {1.000000000e+00f, 9.951847267e-01f, 9.807852804e-01f, 9.569403357e-01f, 9.238795325e-01f, 8.819212643e-01f, 8.314696123e-01f, 7.730104534e-01f, 7.071067812e-01f, 6.343932842e-01f, 5.555702330e-01f, 4.713967368e-01f, 3.826834324e-01f, 2.902846773e-01f, 1.950903220e-01f, 9.801714033e-02f, 6.123233996e-17f, -9.801714033e-02f, -1.950903220e-01f, -2.902846773e-01f, -3.826834324e-01f, -4.713967368e-01f, -5.555702330e-01f, -6.343932842e-01f, -7.071067812e-01f, -7.730104534e-01f, -8.314696123e-01f, -8.819212643e-01f, -9.238795325e-01f, -9.569403357e-01f, -9.807852804e-01f, -9.951847267e-01f, -1.000000000e+00f, -9.951847267e-01f, -9.807852804e-01f, -9.569403357e-01f, -9.238795325e-01f, -8.819212643e-01f, -8.314696123e-01f, -7.730104534e-01f, -7.071067812e-01f, -6.343932842e-01f, -5.555702330e-01f, -4.713967368e-01f, -3.826834324e-01f, -2.902846773e-01f, -1.950903220e-01f, -9.801714033e-02f, -1.836970199e-16f, 9.801714033e-02f, 1.950903220e-01f, 2.902846773e-01f, 3.826834324e-01f, 4.713967368e-01f, 5.555702330e-01f, 6.343932842e-01f, 7.071067812e-01f, 7.730104534e-01f, 8.314696123e-01f, 8.819212643e-01f, 9.238795325e-01f, 9.569403357e-01f, 9.807852804e-01f, 9.951847267e-01f};
constexpr float S64[64] = {0.000000000e+00f, 9.801714033e-02f, 1.950903220e-01f, 2.902846773e-01f, 3.826834324e-01f, 4.713967368e-01f, 5.555702330e-01f, 6.343932842e-01f, 7.071067812e-01f, 7.730104534e-01f, 8.314696123e-01f, 8.819212643e-01f, 9.238795325e-01f, 9.569403357e-01f, 9.807852804e-01f, 9.951847267e-01f, 1.000000000e+00f, 9.951847267e-01f, 9.807852804e-01f, 9.569403357e-01f, 9.238795325e-01f, 8.819212643e-01f, 8.314696123e-01f, 7.730104534e-01f, 7.071067812e-01f, 6.343932842e-01f, 5.555702330e-01f, 4.713967368e-01f, 3.826834324e-01f, 2.902846773e-01f, 1.950903220e-01f, 9.801714033e-02f, 1.224646799e-16f, -9.801714033e-02f, -1.950903220e-01f, -2.902846773e-01f, -3.826834324e-01f, -4.713967368e-01f, -5.555702330e-01f, -6.343932842e-01f, -7.071067812e-01f, -7.730104534e-01f, -8.314696123e-01f, -8.819212643e-01f, -9.238795325e-01f, -9.569403357e-01f, -9.807852804e-01f, -9.951847267e-01f, -1.000000000e+00f, -9.951847267e-01f, -9.807852804e-01f, -9.569403357e-01f, -9.238795325e-01f, -8.819212643e-01f, -8.314696123e-01f, -7.730104534e-01f, -7.071067812e-01f, -6.343932842e-01f, -5.555702330e-01f, -4.713967368e-01f, -3.826834324e-01f, -2.902846773e-01f, -1.950903220e-01f, -9.801714033e-02f};


__device__ __forceinline__ float bf_lo(unsigned v) { return __uint_as_float(v << 16); }
__device__ __forceinline__ float bf_hi(unsigned v) { return __uint_as_float(v & 0xffff0000u); }
__device__ __forceinline__ unsigned pk2(float lo, float hi) { return pg8::cvt_pk_bf16(lo, hi); }
typedef float f32x2_t __attribute__((ext_vector_type(2)));
typedef __bf16 bf16x2_t __attribute__((ext_vector_type(2)));
__device__ __forceinline__ unsigned cvtpk_native(float lo, float hi) { const f32x2_t v = {lo, hi}; const bf16x2_t b = __builtin_convertvector(v, bf16x2_t); return __builtin_bit_cast(unsigned, b); }
__device__ __forceinline__ int hw_tid(int wv_s) { int l; asm volatile("v_mbcnt_lo_u32_b32 %0, -1, 0\n\tv_mbcnt_hi_u32_b32 %0, -1, %0" : "=v"(l)); return wv_s * 64 + l; }
__device__ __forceinline__ float wave_sum(float v) {
#pragma unroll
    for (int o = 1; o < 64; o <<= 1) v += __shfl_xor(v, o);
    return v;
}
template <int CTRL, int RM> __device__ __forceinline__ float dppf(float v) { return __int_as_float(__builtin_amdgcn_update_dpp(0, __float_as_int(v), CTRL, RM, 0xF, false)); }
__device__ __forceinline__ float wave_sum_dpp(float v) {
    v += dppf<0x128, 0xF>(v); v += dppf<0x124, 0xF>(v); v += dppf<0x122, 0xF>(v); v += dppf<0x121, 0xF>(v);
    v += dppf<0x142, 0xA>(v); v += dppf<0x143, 0xC>(v);
    return __int_as_float(__builtin_amdgcn_readlane(__float_as_int(v), 63));
}
__device__ __forceinline__ int row_batch(int r) { return r < M_P ? (r >> 11) : 8 + ((r - M_P) >> 12); }

struct Params { const float* in[19]; float* out; unsigned char* ws; int ph_lo, ph_hi; };

template <int N> __device__ __forceinline__ void fft_dif(float (&re)[N], float (&im)[N]) {
#pragma unroll
    for (int half = N / 2; half >= 1; half >>= 1) {
        const int step = 32 / half;
#pragma unroll
        for (int blk = 0; blk < N; blk += 2 * half) {
#pragma unroll
            for (int j = 0; j < half; ++j) {
                const int i0 = blk + j, i1 = i0 + half, ti = j * step;
                const float ar = re[i0], ai = im[i0], br = re[i1], bi = im[i1];
                re[i0] = ar + br; im[i0] = ai + bi;
                const float dr = ar - br, di = ai - bi;
                if (ti == 0) { re[i1] = dr; im[i1] = di; }
                else if (ti == 16) { re[i1] = di; im[i1] = -dr; }
                else { const float c = C64[ti], s = S64[ti]; re[i1] = dr * c + di * s; im[i1] = di * c - dr * s; }
            }
        }
    }
}
template <int N> __device__ __forceinline__ constexpr int brev(int i) { int r = 0; for (int b = 1, o = N >> 1; b < N; b <<= 1, o >>= 1) if (i & b) r |= o; return r; }

__device__ __forceinline__ void tile_writeout(int K, bf16* WT, int k0, int n0, LAS float* scr, int lane) {
    asm volatile("s_waitcnt lgkmcnt(0)" ::: "memory");
    const int c = lane & 7;
#pragma unroll
    for (int j = 0; j < 4; ++j) { const int n = (lane >> 3) + 8 * j; const LAS float* s = scr + (8 * c) * 33 + n;
        v4u o; o.x = pk2(s[0 * 33], s[1 * 33]); o.y = pk2(s[2 * 33], s[3 * 33]); o.z = pk2(s[4 * 33], s[5 * 33]); o.w = pk2(s[6 * 33], s[7 * 33]);
        *(v4u*)(WT + (size_t)(n0 + n) * K + k0 + 8 * c) = o; }
    asm volatile("s_waitcnt lgkmcnt(0)" ::: "memory");
}
template <class Src> __device__ __forceinline__ void transpose_item(const Src& src, int K, bf16* WT, int k0, int n0, LAS float* scr, int lane) {
    f32x4 v[8];
#pragma unroll
    for (int i = 0; i < 8; ++i) v[i] = src.ld4(k0 + 8 * i + (lane >> 3), n0 + 4 * (lane & 7));
#pragma unroll
    for (int i = 0; i < 8; ++i) { LAS float* d = scr + (8 * i + (lane >> 3)) * 33 + 4 * (lane & 7); d[0] = v[i][0]; d[1] = v[i][1]; d[2] = v[i][2]; d[3] = v[i][3]; }
    tile_writeout(K, WT, k0, n0, scr, lane);
}
__device__ __forceinline__ void fold_item(const float* W  , const LAS float* T, bf16* WT, int k0, int n0, LAS float* scr, int lane) {
    const int q = n0 + (lane & 31) - 1536, m = q >> 1, part = q & 1, g = m >> 6, mm = m & 63;
    float Tr[64];
#pragma unroll
    for (int j = 0; j < 64; ++j) Tr[j] = T[64 * part + ((j * mm) & 63)];
#pragma unroll 2
    for (int i = 0; i < 32; ++i) { const int kk = 2 * i + (lane >> 5); const f32x4* f = (const f32x4*)(W + (size_t)(k0 + kk) * 2048 + 1536 + 64 * g);
        float s0 = 0.f, s1 = 0.f;
#pragma unroll
        for (int jj = 0; jj < 16; jj += 2) { const f32x4 a = f[jj], b = f[jj + 1];
            s0 += (a[0] * Tr[4 * jj] + a[1] * Tr[4 * jj + 1]) + (a[2] * Tr[4 * jj + 2] + a[3] * Tr[4 * jj + 3]);
            s1 += (b[0] * Tr[4 * jj + 4] + b[1] * Tr[4 * jj + 5]) + (b[2] * Tr[4 * jj + 6] + b[3] * Tr[4 * jj + 7]); }
        scr[kk * 33 + (lane & 31)] = s0 + s1; }
    tile_writeout(D, WT, k0, n0, scr, lane);
}
struct SrcPlain { const float* W; int ldw; __device__ __forceinline__ float operator()(int k, int n) const { return W[(size_t)k * ldw + n]; }
    __device__ __forceinline__ f32x4 ld4(int k, int n) const { return *(const f32x4*)(W + (size_t)k * ldw + n); } };
struct SrcIn { const float* W; const LAS float* T;
    __device__ __forceinline__ float operator()(int k, int n) const {
        const float* wr = W + (size_t)k * 2048;
        if (n < 512) return wr[n];
        if (n < 1536) { const int tt = (n - 512) >> 8, c = (n - 512) & 255; return wr[c < 128 ? 512 + 128 * tt + c : 1024 + 128 * tt + (c - 128)]; }
        return wr[n]; }
    __device__ __forceinline__ f32x4 ld4(int k, int n) const {
        const float* wr = W + (size_t)k * 2048; int col = n;
        if (n >= 512 && n < 1536) { const int tt = (n - 512) >> 8, c = (n - 512) & 255; col = c < 128 ? 512 + 128 * tt + c : 1024 + 128 * tt + (c - 128); }
        return *(const f32x4*)(wr + col); } };
struct SrcInUnused { const float* W; __device__ __forceinline__ float f(int k, int n) const { const float* wr = W;
        return wr[n]; } };
struct SrcGU { const float *Wg, *Wu;
    __device__ __forceinline__ float operator()(int k, int n) const { const int j = n >> 8, c = n & 255; return c < 128 ? Wg[(size_t)k * DFF + 128 * j + c] : Wu[(size_t)k * DFF + 128 * j + (c - 128)]; }
    __device__ __forceinline__ f32x4 ld4(int k, int n) const { const int j = n >> 8, c = n & 255; return *(const f32x4*)(c < 128 ? Wg + (size_t)k * DFF + 128 * j + c : Wu + (size_t)k * DFF + 128 * j + (c - 128)); } };

__device__ __forceinline__ void p0_prep(const Params& P, LAS unsigned char* lds, const int wv_s) {
    int tid_ = hw_tid(wv_s); asm volatile("" : "+v"(tid_));
    const int tid = tid_, lane = tid & 63, wave = __builtin_amdgcn_readfirstlane(tid >> 6);
    unsigned char* ws = P.ws;
    LAS float* T = (LAS float*)(lds + MISC_OFF);
    LAS float* cact = (LAS float*)lds;
    LAS float* red = (LAS float*)(lds + 98304);
    if (tid < 64) { T[tid] = cospif((float)tid * (1.0f / 32.0f)); T[64 + tid] = sinpif((float)tid * (1.0f / 32.0f)); }
    for (int i = tid; i < NB * D; i += NTHREADS) { const int b = i >> 10, k = i & 1023; const float c = b < 8 ? P.in[2][b * D + k] : P.in[3][(b - 8) * D + k]; cact[i] = c / (1.0f + __expf(-c)); }
    __syncthreads();
    float* mod = (float*)(ws + WS_MOD);
    for (int item = blockIdx.x; item < DEPTH * 96; item += gridDim.x) {
        const int l = item / 96, n0 = (item % 96) * 64;
        const float* W = P.in[4] + (size_t)l * D * 6144 + n0 + lane;
        float acc[NB];
#pragma unroll
        for (int b = 0; b < NB; ++b) acc[b] = 0.f;
        const int k0 = wave * 128;
        for (int k = k0; k < k0 + 128; k += 8) {
            float w[8];
#pragma unroll
            for (int i = 0; i < 8; ++i) w[i] = W[(size_t)(k + i) * 6144];
#pragma unroll
            for (int b = 0; b < NB; ++b) { const f32x4 c4 = *(const LAS f32x4*)(cact + b * D + k), c5 = *(const LAS f32x4*)(cact + b * D + k + 4);
                acc[b] += ((c4[0] * w[0] + c4[1] * w[1]) + (c4[2] * w[2] + c4[3] * w[3])) + ((c5[0] * w[4] + c5[1] * w[5]) + (c5[2] * w[6] + c5[3] * w[7])); }
        }
#pragma unroll
        for (int b = 0; b < NB; ++b) red[(wave * NB + b) * 64 + lane] = acc[b];
        __syncthreads();
        for (int o = tid; o < NB * 64; o += NTHREADS) { const int b = o >> 6, n = o & 63; float s = 0.f;
#pragma unroll
            for (int w = 0; w < NWAVES; ++w) s += red[(w * NB + b) * 64 + n];
            mod[(size_t)(l * NB + b) * 6144 + n0 + n] = s + P.in[5][l * 6144 + n0 + n]; }
        __syncthreads();
    }
    if (blockIdx.x == 0) { unsigned* bw = (unsigned*)(ws + WS_BAR); for (int i = tid; i < 3456; i += NTHREADS) bw[i] = 0u; }
    { unsigned* cw = (unsigned*)(ws + WS_CNT); for (int i = blockIdx.x * NTHREADS + tid; i < 16 * 320; i += gridDim.x * NTHREADS) cw[64 * i] = 0u; }
    { float2* tw4 = (float2*)(ws + WS_TW4); float2* tw2 = (float2*)(ws + WS_TW2);
      for (int j = blockIdx.x * NTHREADS + tid; j < 4096 + 2048; j += gridDim.x * NTHREADS) {
          if (j < 4096) { float s, c; sincospif((float)j * (1.0f / 2048.0f), &s, &c); tw4[j] = make_float2(c, -s); }
          else { const int jj = j - 4096; float s, c; sincospif((float)jj * (1.0f / 1024.0f), &s, &c); tw2[jj] = make_float2(c, -s); } } }
}
__device__ __forceinline__ void p0_weights(const Params& P, LAS unsigned char* lds, const int wv_s) {
    int tid_ = hw_tid(wv_s); asm volatile("" : "+v"(tid_));
    const int tid = tid_, lane = tid & 63, wave = __builtin_amdgcn_readfirstlane(tid >> 6);
    unsigned char* ws = P.ws;
    LAS float* T = (LAS float*)(lds + MISC_OFF);
    if (tid < 64) { T[tid] = cospif((float)tid * (1.0f / 32.0f)); T[64 + tid] = sinpif((float)tid * (1.0f / 32.0f)); }
    __syncthreads();
    LAS float* scr = (LAS float*)(lds + wave * 8448);
    const int gw = blockIdx.x * NWAVES + wave, NGW = gridDim.x * NWAVES;
    constexpr int I_IN = 16 * 64, I_OUT = 16 * 32, I_GU = 16 * 176, I_DN = 44 * 32, I_L = I_IN + I_OUT + I_GU + I_DN;
    for (int it = gw; it < DEPTH * I_L; it += NGW) {
        const int l = it / I_L; int r = it % I_L;
        if (r < I_IN) { SrcIn s{P.in[8] + (size_t)l * D * 2048, T}; transpose_item(s, D, (bf16*)(ws + WS_WIN) + (size_t)l * N_IN * D, 64 * (r / 64), 32 * (r % 64), scr, lane); continue; } r -= I_IN;
        if (r < I_OUT) { SrcPlain s{P.in[13] + (size_t)l * D * D, D}; transpose_item(s, D, (bf16*)(ws + WS_WOUT) + (size_t)l * D * D, 64 * (r / 32), 32 * (r % 32), scr, lane); continue; } r -= I_OUT;
        if (r < I_GU) { SrcGU s{P.in[16] + (size_t)l * D * DFF, P.in[17] + (size_t)l * D * DFF}; transpose_item(s, D, (bf16*)(ws + WS_WGU) + (size_t)l * N_GU * D, 64 * (r / 176), 32 * (r % 176), scr, lane); continue; } r -= I_GU;
        { SrcPlain s{P.in[18] + (size_t)l * DFF * D, D}; transpose_item(s, DFF, (bf16*)(ws + WS_WDN) + (size_t)l * D * DFF, 64 * (r / 32), 32 * (r % 32), scr, lane); }
    }
}

#ifndef ROWCOOP
#define ROWCOOP 1
#endif
#ifndef NSETB
#define NSETB 2
#endif
#ifndef XBF16
#define XBF16 1
#endif
template <bool BR, bool DOH, bool LAST, bool FIRST> __device__ __forceinline__ void row_range(const Params& P, const int lane, const int r0, const int r1, const int step  , const float* gpost, const float* modg  ,
                                                                         const float* gpre, const float* modsh, const float* modsc) {
    bf16* RA = (bf16*)(P.ws + WS_RA); const float* stats = (const float*)(P.ws + WS_STATS);
    bf16* XB = (bf16*)(P.ws + WS_XB);
    constexpr bool XOUT32 = !XBF16 || LAST;
    constexpr bool XIN32 = !XBF16 || FIRST;
    constexpr int NSET = XIN32 ? 1 : NSETB;
    if (r0 >= r1) return;
    f32x4 gp[4], gq[4], gb[4], ga[4], sh[4];
#pragma unroll
    for (int j = 0; j < 4; ++j) { if (BR) gp[j] = ((const f32x4*)gpost)[lane + 64 * j]; if (DOH) gq[j] = ((const f32x4*)gpre)[lane + 64 * j]; }
    int gb_cur = -1;
    f32x4 xn[NSET][2][4]; v2u xbn[NSET][2][4]; v2u on[NSET][2][4]; float stn[NSET][2];
    auto xptr = [&](int row) -> const float* { return FIRST ? (row < M_P ? P.in[0] + (size_t)row * D : P.in[1] + (size_t)(row - M_P) * D) : P.out + (size_t)row * D; };
#define ROW_LOAD(s, q, row) do { if ((row) < r1) { const float* xr_ = xptr(row); _Pragma("unroll") for (int j = 0; j < 4; ++j) { \
        if (XIN32) xn[s][q][j] = __builtin_nontemporal_load(((const f32x4*)xr_) + lane + 64 * j); else xbn[s][q][j] = __builtin_nontemporal_load(((const v2u*)(XB + (size_t)(row) * D)) + lane + 64 * j); \
        if (BR) on[s][q][j] = __builtin_nontemporal_load(((const v2u*)(RA + (size_t)(row) * D)) + lane + 64 * j); } \
        if (BR) stn[s][q] = stats[(size_t)(row) * 16 + (lane & 15)]; } } while (0)
#pragma unroll
    for (int s = 0; s < NSET; ++s) { ROW_LOAD(s, 0, r0 + step * s); ROW_LOAD(s, 1, r0 + step * s + 1); }
    for (int rowg = r0; rowg < r1; rowg += step * NSET) {
#pragma unroll
        for (int s = 0; s < NSET; ++s) {
            const int rowp = rowg + step * s;
            f32x4 xc[2][4]; v2u oc[2][4]; float stc[2];
#pragma unroll
            for (int q = 0; q < 2; ++q) {
#pragma unroll
                for (int j = 0; j < 4; ++j) { if (XIN32) xc[q][j] = xn[s][q][j]; else xc[q][j] = (f32x4){bf_lo(xbn[s][q][j].x), bf_hi(xbn[s][q][j].x), bf_lo(xbn[s][q][j].y), bf_hi(xbn[s][q][j].y)}; if (BR) oc[q][j] = on[s][q][j]; }
                if (BR) stc[q] = stn[s][q]; }
            ROW_LOAD(s, 0, rowp + step * NSET); ROW_LOAD(s, 1, rowp + step * NSET + 1);
#pragma unroll
            for (int q = 0; q < 2; ++q) {
                const int row = rowp + q;
                if (row < r1) {
                    const int gbt = row_batch(row);
                    if (gbt != gb_cur) { gb_cur = gbt;
#pragma unroll
                        for (int j = 0; j < 4; ++j) { if (BR) gb[j] = ((const f32x4*)(modg + (size_t)gbt * 6144))[lane + 64 * j] * gp[j];
                            if (DOH) { sh[j] = ((const f32x4*)(modsh + (size_t)gbt * 6144))[lane + 64 * j]; ga[j] = (((const f32x4*)(modsc + (size_t)gbt * 6144))[lane + 64 * j] + 1.0f) * gq[j]; } } }
                    f32x4 x[4];
#pragma unroll
                    for (int j = 0; j < 4; ++j) x[j] = xc[q][j];
                    if (BR) {
                        float ss = stc[q]; ss += dppf<0x128, 0xF>(ss); ss += dppf<0x124, 0xF>(ss); ss += dppf<0x122, 0xF>(ss); ss += dppf<0x121, 0xF>(ss);
                        const float rinv = rsqrtf(ss * (1.0f / D) + EPS);
#pragma unroll
                        for (int j = 0; j < 4; ++j) {
                            const v2u o = oc[q][j];
                            x[j][0] += gb[j][0] * (bf_lo(o.x) * rinv); x[j][1] += gb[j][1] * (bf_hi(o.x) * rinv);
                            x[j][2] += gb[j][2] * (bf_lo(o.y) * rinv); x[j][3] += gb[j][3] * (bf_hi(o.y) * rinv);
                        }
#pragma unroll
                        for (int j = 0; j < 4; ++j) { if (XOUT32) __builtin_nontemporal_store(x[j], ((f32x4*)(P.out + (size_t)row * D)) + lane + 64 * j);
                            else { v2u w; w.x = pk2(x[j][0], x[j][1]); w.y = pk2(x[j][2], x[j][3]); ((v2u*)(XB + (size_t)row * D))[lane + 64 * j] = w;
                                   x[j] = (f32x4){bf_lo(w.x), bf_hi(w.x), bf_lo(w.y), bf_hi(w.y)}; } }
                    }
                    if (DOH) {
                        float s2 = 0.f;
#pragma unroll
                        for (int j = 0; j < 4; ++j) s2 += (x[j][0] * x[j][0] + x[j][1] * x[j][1]) + (x[j][2] * x[j][2] + x[j][3] * x[j][3]);
                        s2 = wave_sum_dpp(s2);
                        const float r2 = rsqrtf(s2 * (1.0f / D) + EPS);
#pragma unroll
                        for (int j = 0; j < 4; ++j) {
                            f32x4 h;
#pragma unroll
                            for (int e = 0; e < 4; ++e) h[e] = (x[j][e] * r2) * ga[j][e] + sh[j][e];
                            v2u w; w.x = pk2(h[0], h[1]); w.y = pk2(h[2], h[3]);
                            ((v2u*)(RA + (size_t)row * D))[lane + 64 * j] = w;
                        }
                    }
                }
            }
        }
    }
#undef ROW_LOAD
}
template <bool BR, bool DOH, bool LAST, bool FIRST> __device__ __forceinline__ void row_phase(const Params& P, const int wv_s, const float* gpost, const float* modg, const float* gpre, const float* modsh, const float* modsc) {
    int tid_ = hw_tid(wv_s); asm volatile("" : "+v"(tid_));
    const int lane = tid_ & 63, wave = __builtin_amdgcn_readfirstlane(tid_ >> 6);
    const int gw = blockIdx.x * NWAVES + wave, NGW = gridDim.x * NWAVES;
    const int rpw = (M + NGW - 1) / NGW, r0 = gw * rpw, r1 = (r0 + rpw < M) ? r0 + rpw : M;
#if ROWCOOP
    { const int rpb = rpw * NWAVES, b0 = blockIdx.x * rpb, b1 = (b0 + rpb < M) ? b0 + rpb : M;
      row_range<BR, DOH, LAST, FIRST>(P, lane, b0 + 2 * wave, b1, 2 * NWAVES, gpost, modg, gpre, modsh, modsc); }
#else
    row_range<BR, DOH, LAST, FIRST>(P, lane, r0, r1, 2, gpost, modg, gpre, modsh, modsc);
#endif
}
__device__ __forceinline__ unsigned gload_row(const void* rowp  , unsigned voff) { unsigned v; asm volatile("global_load_dword %0, %1, %2" : "=v"(v) : "v"(voff), "s"(rowp) : "memory"); return v; }
#define TIE16(a, o) asm volatile("" : "+v"(a[o + 0]), "+v"(a[o + 1]), "+v"(a[o + 2]), "+v"(a[o + 3]), "+v"(a[o + 4]), "+v"(a[o + 5]), "+v"(a[o + 6]), "+v"(a[o + 7]), \
                                      "+v"(a[o + 8]), "+v"(a[o + 9]), "+v"(a[o + 10]), "+v"(a[o + 11]), "+v"(a[o + 12]), "+v"(a[o + 13]), "+v"(a[o + 14]), "+v"(a[o + 15]))
__device__ __forceinline__ void f1_phase(const Params& P, LAS unsigned char* lds, const int wv_s) {
    typedef short bf16x8 __attribute__((ext_vector_type(8)));
    typedef float f32x2v __attribute__((ext_vector_type(2)));
    int tid_ = hw_tid(wv_s); asm volatile("" : "+v"(tid_));
    const int m = tid_, lane = m & 63, wave = __builtin_amdgcn_readfirstlane(m >> 6), l15 = lane & 15, quad = lane >> 4;
    const bf16* F = (const bf16*)(P.ws + WS_RB + (size_t)M * 1024 * 2);
    unsigned* Y = (unsigned*)(P.ws + WS_RA);
    LAS unsigned char* Pl = lds + wave * 16384;
    LAS unsigned char* Dt = lds + 131072;
    LAS f32x2v* ltw = (LAS f32x2v*)(lds + MISC_OFF + 1024);
    for (int i = m; i < 128 * 32; i += NTHREADS) { const int n = i >> 5, j = 2 * (i & 31), mm = n >> 1; float s0, c0, s1, c1;
        sincospif((float)((j * mm) & 63) * (1.0f / 32.0f), &s0, &c0); sincospif((float)(((j + 1) * mm) & 63) * (1.0f / 32.0f), &s1, &c1);
        *(LAS unsigned*)(Dt + n * 128 + j * 2) = (n & 1) ? pk2(-s0, -s1) : pk2(c0, c1); }
    __syncthreads();
    int par = 0;
    for (int item = blockIdx.x; item < 1024 + 256; item += gridDim.x, par ^= 1) {
        int base, N1, t1; const float2* tw;
        if (item < 1024) { base = M_P + (item >> 6) * 4096; t1 = item & 63; N1 = 64; tw = (const float2*)(P.ws + WS_TW4); }
        else { const int it = item - 1024; base = (it >> 5) * 2048; t1 = it & 31; N1 = 32; tw = (const float2*)(P.ws + WS_TW2); }
        if (m < 64) { const float2 w0 = tw[m * t1]; ltw[par * 64 + m] = (f32x2v){w0.x, w0.y}; }
        bf16x8 fb[4][2];
#pragma unroll
        for (int tt = 0; tt < 4; ++tt)
#pragma unroll
            for (int kk = 0; kk < 2; ++kk) fb[tt][kk] = *(const bf16x8*)(F + (size_t)(base + t1 + N1 * (16 * tt + l15)) * 512 + 64 * wave + 32 * kk + 8 * quad);
#pragma unroll
        for (int nt = 0; nt < 8; ++nt) {
            const bf16x8 a0 = *(const LAS bf16x8*)(Dt + (16 * nt + l15) * 128 + (8 * quad) * 2), a1 = *(const LAS bf16x8*)(Dt + (16 * nt + l15) * 128 + (32 + 8 * quad) * 2);
#pragma unroll
            for (int tt = 0; tt < 4; ++tt) {
                f32x4 acc = {0.f, 0.f, 0.f, 0.f};
                acc = __builtin_amdgcn_mfma_f32_16x16x32_bf16(a0, fb[tt][0], acc, 0, 0, 0);
                acc = __builtin_amdgcn_mfma_f32_16x16x32_bf16(a1, fb[tt][1], acc, 0, 0, 0);
                v2u w; w.x = cvtpk_native(acc[0], acc[1]); w.y = cvtpk_native(acc[2], acc[3]);
                *(LAS v2u*)(Pl + (16 * tt + l15) * 256 + (16 * nt + 4 * quad) * 2) = w;
            }
        }
        asm volatile("s_waitcnt lgkmcnt(0)" ::: "memory");
        float re[64], im[64];
#pragma unroll
        for (int t2 = 0; t2 < 64; ++t2) { const unsigned v = *(const LAS unsigned*)(Pl + t2 * 256 + lane * 4); re[t2] = bf_lo(v); im[t2] = bf_hi(v); }
        fft_dif<64>(re, im);
        __syncthreads();
        int base2 = base; asm volatile("" : "+s"(base2));
#pragma unroll
        for (int i = 0; i < 64; ++i) { const int k2 = brev<64>(i); const f32x2v w = ltw[par * 64 + k2];
            const float yr = re[i] * w.x - im[i] * w.y, yi = re[i] * w.y + im[i] * w.x;
            Y[(size_t)(base2 + t1 * 64 + k2) * 512 + m] = pk2(yr, yi); }
    }
}
template <int N1> __device__ __forceinline__ void f2_fft_part(const Params& P, const int wv_s, int l, int base, int k2, LAS float* red, LAS float* rinv) {
    int tid_ = hw_tid(wv_s); asm volatile("" : "+v"(tid_));
    const int m = tid_, lane = m & 63, wave = __builtin_amdgcn_readfirstlane(m >> 6);
    const unsigned* Y = (const unsigned*)(P.ws + WS_RA);
    bf16* MG = (bf16*)(P.ws + WS_RB + (size_t)M * 1024 * 2);
    unsigned raw[N1]; const unsigned moff = (unsigned)m * 4u;
#pragma unroll
    for (int t1 = 0; t1 < N1; ++t1) raw[t1] = gload_row((const char*)Y + (size_t)(base + t1 * 64 + k2) * 2048, moff);
    asm volatile("s_waitcnt vmcnt(0)" ::: "memory");
    TIE16(raw, 0); TIE16(raw, 16); if constexpr (N1 == 64) { TIE16(raw, 32); TIE16(raw, 48); }
    float re[N1], im[N1];
#pragma unroll
    for (int t1 = 0; t1 < N1; ++t1) { re[t1] = bf_lo(raw[t1]); im[t1] = bf_hi(raw[t1]); }
    fft_dif<N1>(re, im);
#pragma unroll
    for (int i = 0; i < N1; ++i) { const float s = wave_sum_dpp(re[i] * re[i]); if (lane == 0) red[wave * 64 + i] = s; }
    __syncthreads();
    if (m < N1) { float s = 0.f;
#pragma unroll
        for (int w = 0; w < NWAVES; ++w) s += red[w * 64 + m];
        rinv[m] = rsqrtf(s * (1.0f / 512.0f) + EPS); }
    __syncthreads();
    const float g = P.in[12][l * 512 + m];
    int base2 = base; asm volatile("" : "+s"(base2));
#pragma unroll
    for (int i = 0; i < N1; ++i) { const int k1 = brev<N1>(i); const float v = re[i] * rinv[i] * g;
        MG[(size_t)(base2 + 64 * k1 + k2) * 1024 + 512 + m] = (bf16)(pk2(v, 0.f) & 0xffffu); if ((i & 7) == 7) __builtin_amdgcn_sched_barrier(0); }
    __syncthreads();
}
__device__ __forceinline__ void f2_phase(const Params& P, int l, LAS unsigned char* lds, const int wv_s) {
    int tid_ = hw_tid(wv_s); asm volatile("" : "+v"(tid_));
    const int lane = tid_ & 63, wave = __builtin_amdgcn_readfirstlane(tid_ >> 6);
    LAS float* red = (LAS float*)lds; LAS float* rinv = red + 512;
    const bf16* BG = (const bf16*)(P.ws + WS_RB); const bf16* U = BG + (size_t)M * 512;
    bf16* MG = (bf16*)(P.ws + WS_RB + (size_t)M * 1024 * 2);
    for (int item = blockIdx.x; item < 1024 + 512; item += gridDim.x) {
        int base, N1, k2, S;
        if (item < 1024) { base = M_P + (item >> 6) * 4096; k2 = item & 63; N1 = 64; S = 4096; f2_fft_part<64>(P, wv_s, l, base, k2, red, rinv); }
        else { const int it = item - 1024; base = (it >> 6) * 2048; k2 = it & 63; N1 = 32; S = 2048; f2_fft_part<32>(P, wv_s, l, base, k2, red, rinv); }
        f32x4 cw[3][2], cb[2], gc[2];
#pragma unroll
        for (int h = 0; h < 2; ++h) {
#pragma unroll
            for (int t = 0; t < 3; ++t) cw[t][h] = *(const f32x4*)(P.in[9] + (size_t)l * 3 * 512 + t * 512 + 8 * lane + 4 * h);
            cb[h] = *(const f32x4*)(P.in[10] + l * 512 + 8 * lane + 4 * h); gc[h] = *(const f32x4*)(P.in[11] + l * 512 + 8 * lane + 4 * h); }
        for (int kb = 0; kb < N1 / NWAVES; kb += 4) {
            v4u bgv[4], u0[4], um[4], up[4];
#pragma unroll
            for (int q = 0; q < 4; ++q) { const int t = 64 * (wave + NWAVES * (kb + q)) + k2; const size_t row = (size_t)(base + t); const v4u zero = {0u, 0u, 0u, 0u};
                bgv[q] = *(const v4u*)(BG + row * 512 + 8 * lane); u0[q] = *(const v4u*)(U + row * 512 + 8 * lane);
                um[q] = t > 0 ? *(const v4u*)(U + (row - 1) * 512 + 8 * lane) : zero; up[q] = t < S - 1 ? *(const v4u*)(U + (row + 1) * 512 + 8 * lane) : zero; }
#pragma unroll
            for (int q = 0; q < 4; ++q) { const int t = 64 * (wave + NWAVES * (kb + q)) + k2; const size_t row = (size_t)(base + t);
                float co[8]; float ss = 0.f;
#pragma unroll
                for (int e = 0; e < 4; ++e) {
                    const int h = e >> 1, c0 = 2 * (e & 1);
                    const float a0 = cw[0][h][c0] * bf_lo(um[q][e]) + cw[1][h][c0] * bf_lo(u0[q][e]) + cw[2][h][c0] * bf_lo(up[q][e]) + cb[h][c0];
                    const float a1 = cw[0][h][c0 + 1] * bf_hi(um[q][e]) + cw[1][h][c0 + 1] * bf_hi(u0[q][e]) + cw[2][h][c0 + 1] * bf_hi(up[q][e]) + cb[h][c0 + 1];
                    co[2 * e] = bf_lo(bgv[q][e]) * a0; co[2 * e + 1] = bf_hi(bgv[q][e]) * a1; ss += co[2 * e] * co[2 * e] + co[2 * e + 1] * co[2 * e + 1];
                }
                ss = wave_sum_dpp(ss);
                const float ri = rsqrtf(ss * (1.0f / 512.0f) + EPS);
                v4u w;
#pragma unroll
                for (int e = 0; e < 4; ++e) { const int h = e >> 1, c0 = 2 * (e & 1); w[e] = pk2(co[2 * e] * ri * gc[h][c0], co[2 * e + 1] * ri * gc[h][c0 + 1]); }
                *(v4u*)(MG + row * 1024 + 8 * lane) = w; }
        }
    }
}

#ifndef EFUSE
#define EFUSE 1
#endif
__device__ __forceinline__ bool panel_exchange(float part  , const int tid, float* slots, unsigned* cnt, const int pm, const int pn, LAS float* S, const float inv_n) {
    if (tid < 256) {
        __hip_atomic_store(slots + ((size_t)(pm * 256 + tid)) * 4 + pn, part, __ATOMIC_RELAXED, __HIP_MEMORY_SCOPE_AGENT);
        asm volatile("s_waitcnt vmcnt(0)" ::: "memory");
        if ((tid & 63) == 0) __hip_atomic_fetch_add(cnt + 64 * pm, 1u, __ATOMIC_RELAXED, __HIP_MEMORY_SCOPE_AGENT);
    }
    if (tid == 0) { unsigned sp = 0u;
        while (__hip_atomic_load(cnt + 64 * pm, __ATOMIC_RELAXED, __HIP_MEMORY_SCOPE_AGENT) < 16u) { __builtin_amdgcn_s_sleep(1); if (++sp > (1u << 22)) break; } }
    __syncthreads();
    if (tid < 256) { const float* q = slots + ((size_t)(pm * 256 + tid)) * 4;
        const float t = (__hip_atomic_load(q + 0, __ATOMIC_RELAXED, __HIP_MEMORY_SCOPE_AGENT) + __hip_atomic_load(q + 1, __ATOMIC_RELAXED, __HIP_MEMORY_SCOPE_AGENT))
                      + (__hip_atomic_load(q + 2, __ATOMIC_RELAXED, __HIP_MEMORY_SCOPE_AGENT) + __hip_atomic_load(q + 3, __ATOMIC_RELAXED, __HIP_MEMORY_SCOPE_AGENT));
        S[tid] = rsqrtf(t * inv_n + EPS); }
    __syncthreads();
    return true;
}
template <bool DOH, bool LAST, bool FIRST> struct EpiFuse {
    static constexpr bool PERM = true, AFTER_DRAIN = false;
    const Params* P; LAS unsigned char* lds; int wv_s, inst;
    const float *gpost, *modg, *gpre, *modsh, *modsc;
    __device__ __forceinline__ void operator()(const pg8::f32x4 (&acc_c)[2][2][4][2], const pg8::Unit& u, int wr, int wc, int fr, int fq) const {
        typedef pg8::f32x4 (&AccRef)[2][2][4][2];
        AccRef acc = const_cast<AccRef>(acc_c);
        const int ln = fq * 16 + fr, tid = wv_s * 64 + ln;
        LAS float* Pt = (LAS float*)(lds + 131072);
        LAS float* S = (LAS float*)(lds + 131072 + 4096);
        unsigned char* ws = P->ws;
        float* slots = (float*)(ws + WS_SLOT) + (size_t)(2 * inst) * M * 4; unsigned* cnt = (unsigned*)(ws + WS_CNT) + (size_t)(2 * inst) * 320 * 64;
        const int row0 = u.pm * 256 + wr * 64 + fr, cl = u.pn * 256 + wc * 32 + 8 * fq, gbt = row_batch(u.pm * 256);
        bf16* XB = (bf16*)(ws + WS_XB); bf16* RA = (bf16*)(ws + WS_RA);
#pragma unroll
        for (int ai = 0; ai < 2; ++ai)
#pragma unroll
            for (int m = 0; m < 4; ++m) { float sq = 0.f;
#pragma unroll
                for (int bj = 0; bj < 2; ++bj)
#pragma unroll
                    for (int n = 0; n < 2; ++n) { const pg8::f32x4 a = acc[ai][bj][m][n]; sq += (a[0] * a[0] + a[1] * a[1]) + (a[2] * a[2] + a[3] * a[3]); }
                sq += __int_as_float(__builtin_amdgcn_ds_bpermute((ln ^ 16) << 2, __float_as_int(sq))); sq += __int_as_float(__builtin_amdgcn_ds_bpermute((ln ^ 32) << 2, __float_as_int(sq)));
                if (fq == 0) Pt[(ai * 128 + wr * 64 + m * 16 + fr) * 4 + wc] = sq; }
        __syncthreads();
        float part = 0.f;
        if (tid < 256) { const pg8::f32x4 t4 = *(const LAS pg8::f32x4*)(Pt + tid * 4); part = (t4[0] + t4[1]) + (t4[2] + t4[3]); }
        panel_exchange(part, tid, slots, cnt, u.pm, u.pn, S, 1.0f / D);
        pg8::f32x4 gb[2][2];
#pragma unroll
        for (int bj = 0; bj < 2; ++bj)
#pragma unroll
            for (int n = 0; n < 2; ++n) gb[bj][n] = *(const pg8::f32x4*)(modg + (size_t)gbt * 6144 + cl + 128 * bj + 4 * n) * *(const pg8::f32x4*)(gpost + cl + 128 * bj + 4 * n);
        float s2[2][4];
        constexpr int NCH = FIRST ? 4 : 2, MPC = 8 / NCH;
#pragma unroll
        for (int aih = 0; aih < NCH; ++aih) { const int ai = aih / (NCH / 2), mb = (aih % (NCH / 2)) * MPC;
            pg8::u32x4 xb[4][2]; pg8::f32x4 xf[4][2][2];
#pragma unroll
            for (int m = mb; m < mb + MPC; ++m)
#pragma unroll
                for (int bj = 0; bj < 2; ++bj) { const int row = row0 + ai * 128 + m * 16;
                    if (FIRST) { const float* xr = (row < M_P ? P->in[0] + (size_t)row * D : P->in[1] + (size_t)(row - M_P) * D) + cl + 128 * bj; xf[m][bj][0] = *(const pg8::f32x4*)xr; xf[m][bj][1] = *(const pg8::f32x4*)(xr + 4); }
                    else xb[m][bj] = *(const pg8::u32x4*)(XB + (size_t)row * D + cl + 128 * bj); }
#pragma unroll
            for (int m = mb; m < mb + MPC; ++m) { const int row = row0 + ai * 128 + m * 16; const float rinv = S[ai * 128 + wr * 64 + m * 16 + fr]; float sq = 0.f;
#pragma unroll
                for (int bj = 0; bj < 2; ++bj) {
                    pg8::f32x4 x0, x1;
                    if (FIRST) { x0 = xf[m][bj][0]; x1 = xf[m][bj][1]; }
                    else { const pg8::u32x4 w = xb[m][bj]; x0 = (pg8::f32x4){bf_lo(w.x), bf_hi(w.x), bf_lo(w.y), bf_hi(w.y)}; x1 = (pg8::f32x4){bf_lo(w.z), bf_hi(w.z), bf_lo(w.w), bf_hi(w.w)}; }
                    x0 += gb[bj][0] * (acc[ai][bj][m][0] * rinv); x1 += gb[bj][1] * (acc[ai][bj][m][1] * rinv);
                    if (LAST) { float* orow = P->out + (size_t)row * D + cl + 128 * bj; *(pg8::f32x4*)orow = x0; *(pg8::f32x4*)(orow + 4) = x1; }
                    else { pg8::u32x4 w; w.x = cvtpk_native(x0[0], x0[1]); w.y = cvtpk_native(x0[2], x0[3]); w.z = cvtpk_native(x1[0], x1[1]); w.w = cvtpk_native(x1[2], x1[3]);
                        *(pg8::u32x4*)(XB + (size_t)row * D + cl + 128 * bj) = w;
                        x0 = (pg8::f32x4){bf_lo(w.x), bf_hi(w.x), bf_lo(w.y), bf_hi(w.y)}; x1 = (pg8::f32x4){bf_lo(w.z), bf_hi(w.z), bf_lo(w.w), bf_hi(w.w)}; }
                    acc[ai][bj][m][0] = x0; acc[ai][bj][m][1] = x1;
                    sq += ((x0[0] * x0[0] + x0[1] * x0[1]) + (x0[2] * x0[2] + x0[3] * x0[3])) + ((x1[0] * x1[0] + x1[1] * x1[1]) + (x1[2] * x1[2] + x1[3] * x1[3]));
                }
                s2[ai][m] = sq; }
        }
        if (DOH) {
#pragma unroll
            for (int ai = 0; ai < 2; ++ai)
#pragma unroll
                for (int m = 0; m < 4; ++m) { float sq = s2[ai][m];
                    sq += __int_as_float(__builtin_amdgcn_ds_bpermute((ln ^ 16) << 2, __float_as_int(sq))); sq += __int_as_float(__builtin_amdgcn_ds_bpermute((ln ^ 32) << 2, __float_as_int(sq)));
                    if (fq == 0) Pt[(ai * 128 + wr * 64 + m * 16 + fr) * 4 + wc] = sq; }
            __syncthreads();
            float part2 = 0.f;
            if (tid < 256) { const pg8::f32x4 t4 = *(const LAS pg8::f32x4*)(Pt + tid * 4); part2 = (t4[0] + t4[1]) + (t4[2] + t4[3]); }
            panel_exchange(part2, tid, slots + (size_t)M * 4, cnt + 320 * 64, u.pm, u.pn, S, 1.0f / D);
            pg8::f32x4 ga[2][2], sh[2][2];
#pragma unroll
            for (int bj = 0; bj < 2; ++bj)
#pragma unroll
                for (int n = 0; n < 2; ++n) { const int c = cl + 128 * bj + 4 * n;
                    ga[bj][n] = (*(const pg8::f32x4*)(modsc + (size_t)gbt * 6144 + c) + 1.0f) * *(const pg8::f32x4*)(gpre + c); sh[bj][n] = *(const pg8::f32x4*)(modsh + (size_t)gbt * 6144 + c); }
#pragma unroll
            for (int ai = 0; ai < 2; ++ai)
#pragma unroll
                for (int m = 0; m < 4; ++m) { const int row = row0 + ai * 128 + m * 16; const float r2 = S[ai * 128 + wr * 64 + m * 16 + fr];
#pragma unroll
                    for (int bj = 0; bj < 2; ++bj) { const pg8::f32x4 h0 = (acc[ai][bj][m][0] * r2) * ga[bj][0] + sh[bj][0], h1 = (acc[ai][bj][m][1] * r2) * ga[bj][1] + sh[bj][1];
                        pg8::u32x4 w; w.x = cvtpk_native(h0[0], h0[1]); w.y = cvtpk_native(h0[2], h0[3]); w.z = cvtpk_native(h1[0], h1[1]); w.w = cvtpk_native(h1[2], h1[3]);
                        *(pg8::u32x4*)(RA + (size_t)row * D + cl + 128 * bj) = w; } }
        }
        __syncthreads();
    }
};
#define XB_TMO      128
#define XB_XCNT(j)  (256  + 64 * (j))
#define XB_XSUB(j)  (1280 + 64 * (j))
#define XB_XGEN(j)  (2304 + 64 * (j))
#define XB_TOP      3328
#define XB_TOPGEN   3392
#define XCD_BAR_WORDS 3456
#define XB_SPIN_CAP (1u << 18)

__device__ __forceinline__ unsigned xb_ld(unsigned* p)              { return __hip_atomic_load(p, __ATOMIC_RELAXED, __HIP_MEMORY_SCOPE_AGENT); }
__device__ __forceinline__ unsigned xb_add(unsigned* p, unsigned v) { return __hip_atomic_fetch_add(p, v, __ATOMIC_RELAXED, __HIP_MEMORY_SCOPE_AGENT); }
__device__ __forceinline__ unsigned xb_xcc_id() { return (unsigned)__builtin_amdgcn_s_getreg((3 << 11) | 20) & 0xFu; }
#define XB_SPIN(cond, bar) do { unsigned _sp = 0; while (cond) { __builtin_amdgcn_s_sleep(1); \
    if ((++_sp & 255u) == 0u) { if (xb_ld(&(bar)[XB_TMO])) break; if (_sp > XB_SPIN_CAP) { atomicAdd(&(bar)[XB_TMO], 1u); break; } } } } while (0)

struct XcdBarrier {
    unsigned* bar; unsigned x;
    volatile LAS unsigned* st;
};

__device__ __forceinline__ XcdBarrier xcd_barrier_post(unsigned* bar, volatile LAS unsigned* st) {
    XcdBarrier b; b.bar = bar; b.x = xb_xcc_id(); b.st = st;
    if (threadIdx.x == 0) (void)xb_add(&bar[XB_XCNT(b.x)], 1u);
    return b;
}
__device__ __forceinline__ void xcd_barrier_complete(unsigned* bar, unsigned x, unsigned& nloc, unsigned& nx) {
    const unsigned G = gridDim.x * gridDim.y * gridDim.z;
    unsigned sum, cnt, mine, sp = 0u;
    for (;;) {
        sum = 0u; cnt = 0u; mine = 0u;
#pragma unroll
        for (unsigned j = 0; j < 16; ++j) { const unsigned c = xb_ld(&bar[XB_XCNT(j)]); sum += c; cnt += (c > 0u) ? 1u : 0u; mine = (j == x) ? c : mine; }
        if (sum == G) break;
        __builtin_amdgcn_s_sleep(1);
        if ((++sp & 255u) == 0u) { if (xb_ld(&bar[XB_TMO])) break; if (sp > XB_SPIN_CAP) { atomicAdd(&bar[XB_TMO], 1u); break; } }
    }
    nloc = mine > 0u ? mine : 1u; nx = cnt > 0u ? cnt : 1u;
}

__device__ __forceinline__ void xcd_barrier(const XcdBarrier& b) {
    asm volatile("s_waitcnt vmcnt(0)" ::: "memory");
    __syncthreads();
    if (threadIdx.x == 0) {
        unsigned* bar = b.bar;
        __builtin_amdgcn_s_waitcnt(0);
        unsigned nloc = b.st[0], nx = b.st[1];
        if (nloc == 0u) { xcd_barrier_complete(bar, b.x, nloc, nx); b.st[0] = nloc; b.st[1] = nx; }
        const unsigned old = xb_add(&bar[XB_XSUB(b.x)], 1u);
        const unsigned gen = old / nloc;
        if (old + 1u == (gen + 1u) * nloc) {
            __builtin_amdgcn_fence(__ATOMIC_RELEASE, "agent");
            asm volatile("s_waitcnt vmcnt(0)" ::: "memory");
            const unsigned og = xb_add(&bar[XB_TOP], 1u);
            const unsigned tg = og / nx;
            if (og + 1u == (tg + 1u) * nx) xb_add(&bar[XB_TOPGEN], 1u);
            else XB_SPIN(xb_ld(&bar[XB_TOPGEN]) == tg, bar);
            __builtin_amdgcn_fence(__ATOMIC_ACQUIRE, "agent");
            xb_add(&bar[XB_XGEN(b.x)], 1u);
            asm volatile("s_waitcnt vmcnt(0)" ::: "memory");
        } else {
            XB_SPIN(xb_ld(&bar[XB_XGEN(b.x)]) == gen, bar);
            __builtin_amdgcn_fence(__ATOMIC_ACQUIRE, "agent");
            asm volatile("s_waitcnt vmcnt(0)" ::: "memory");
        }
    }
    __syncthreads();
}

#ifndef REP_P0
#define REP_P0 0
#endif
#ifndef REP_SYNC
#define REP_SYNC 0
#endif
#ifndef REP_N0
#define REP_N0 0
#endif
#ifndef RFUSE
#define RFUSE 0
#endif
#ifndef REPMASK
#define REPMASK 0
#endif
#ifndef PHM
#define PHM 0xffff
#endif
constexpr int N_PHASES = 2 + 8 * DEPTH;
__global__ void __launch_bounds__(NTHREADS, 2) fwd_kernel(Params P) {
    extern __shared__ __attribute__((aligned(16))) unsigned char lds_raw[];
    LAS unsigned char* lds = (LAS unsigned char*)lds_raw;
    const int wv_s = __builtin_amdgcn_readfirstlane(threadIdx.x >> 6);
    unsigned char* ws = P.ws;
    const float* mod = (const float*)(ws + WS_MOD);
    bf16* RA = (bf16*)(ws + WS_RA); bf16* RB = (bf16*)(ws + WS_RB);
    float* stats = (float*)(ws + WS_STATS);
    volatile LAS unsigned* bst = (volatile LAS unsigned*)(lds + MISC_OFF + 512);
    if (threadIdx.x == 0) { bst[0] = 0u; bst[1] = 0u; }
    __syncthreads();
    XcdBarrier bar; bar.bar = (unsigned*)(ws + WS_BAR); bar.x = 0; bar.st = bst;
    for (int ph = P.ph_lo; ph < P.ph_hi; ++ph) {
        if (ph == 0) p0_prep(P, lds, wv_s);
        else if (ph == 1) { p0_weights(P, lds, wv_s); row_phase<false, true, false, true>(P, wv_s, nullptr, nullptr, P.in[6], mod + 0 * D, mod + 1 * D); }
        else {
            const int l = (ph - 2) >> 3, s = (ph - 2) & 7;
            const float* modl = mod + (size_t)l * NB * 6144;
            const bool fuse = EFUSE && XBF16 && gridDim.x == 256;
            if (fuse && (s == 4 || s == 7)) continue;
            if (s == 0) { pg8::Gemm g{RA, (const bf16*)(ws + WS_WIN) + (size_t)l * N_IN * D, M, N_IN, D}; pg8::StaticOrder S; S.init(M, N_IN, gridDim.x, blockIdx.x);
                pg8::EpiIn E{RB, RB + (size_t)M * 512, RB + (size_t)M * 1024};
                pg8::gemm_phase<pg8::EpiIn, pg8::StaticOrder, true, true>(lds, g, S, E, wv_s); }
            else if (s == 1) f1_phase(P, lds, wv_s);
            else if (s == 2) f2_phase(P, l, lds, wv_s);
            else if (s == 3) { pg8::Gemm g{RB + (size_t)M * 1024, (const bf16*)(ws + WS_WOUT) + (size_t)l * D * D, M, D, D}; pg8::StaticOrder S; S.init(M, D, gridDim.x, blockIdx.x);
                if (fuse) {
                    if (l == 0) { EpiFuse<true, false, true> E{&P, lds, wv_s, 2 * l, P.in[7] + l * D, modl + 2 * D, P.in[14] + l * D, modl + 3 * D, modl + 4 * D};
                        pg8::gemm_phase<EpiFuse<true, false, true>, pg8::StaticOrder, true, true>(lds, g, S, E, wv_s); }
                    else { EpiFuse<true, false, false> E{&P, lds, wv_s, 2 * l, P.in[7] + l * D, modl + 2 * D, P.in[14] + l * D, modl + 3 * D, modl + 4 * D};
                        pg8::gemm_phase<EpiFuse<true, false, false>, pg8::StaticOrder, true, true>(lds, g, S, E, wv_s); } }
                else { pg8::EpiOS E{RA, stats};
                pg8::gemm_phase<pg8::EpiOS, pg8::StaticOrder, true, true>(lds, g, S, E, wv_s); } }
            else if (s == 4) { if (l == 0) row_phase<true, true, false, true>(P, wv_s, P.in[7] + l * D, modl + 2 * D, P.in[14] + l * D, modl + 3 * D, modl + 4 * D);
                               else row_phase<true, true, false, false>(P, wv_s, P.in[7] + l * D, modl + 2 * D, P.in[14] + l * D, modl + 3 * D, modl + 4 * D); }
            else if (s == 5) { pg8::Gemm g{RA, (const bf16*)(ws + WS_WGU) + (size_t)l * N_GU * D, M, N_GU, D}; pg8::StaticOrder S; S.init(M, N_GU, gridDim.x, blockIdx.x);
                pg8::EpiAct E{RB};
                pg8::gemm_phase<pg8::EpiAct, pg8::StaticOrder, true, true>(lds, g, S, E, wv_s); }
            else if (s == 6) { pg8::Gemm g{RB, (const bf16*)(ws + WS_WDN) + (size_t)l * D * DFF, M, D, DFF}; pg8::StaticOrder S; S.init(M, D, gridDim.x, blockIdx.x);
                if (fuse) {
                    if (l < DEPTH - 1) { EpiFuse<true, false, false> E{&P, lds, wv_s, 2 * l + 1, P.in[15] + l * D, modl + 5 * D, P.in[6] + (l + 1) * D, modl + NB * 6144 + 0 * D, modl + NB * 6144 + 1 * D};
                        pg8::gemm_phase<EpiFuse<true, false, false>, pg8::StaticOrder, true, true>(lds, g, S, E, wv_s); }
                    else { EpiFuse<false, true, false> E{&P, lds, wv_s, 2 * l + 1, P.in[15] + l * D, modl + 5 * D, nullptr, nullptr, nullptr};
                        pg8::gemm_phase<EpiFuse<false, true, false>, pg8::StaticOrder, true, true>(lds, g, S, E, wv_s); } }
                else { pg8::EpiOS E{RA, stats};
                pg8::gemm_phase<pg8::EpiOS, pg8::StaticOrder, true, true>(lds, g, S, E, wv_s); } }
            else { if (l < DEPTH - 1) row_phase<true, true, false, false>(P, wv_s, P.in[15] + l * D, modl + 5 * D, P.in[6] + (l + 1) * D, modl + NB * 6144 + 0 * D, modl + NB * 6144 + 1 * D);
                   else row_phase<true, false, true, false>(P, wv_s, P.in[15] + l * D, modl + 5 * D, nullptr, nullptr, nullptr); }
        }
        if (ph + 1 < P.ph_hi) {
            if (ph == 0) { __syncthreads(); cg::this_grid().sync(); bar = xcd_barrier_post((unsigned*)(ws + WS_BAR), bst); }
            else xcd_barrier(bar);
        }
    }
}

extern "C" void kernel_launch(void* const* d_in, const int* in_sizes, int n_in, void* d_out, int out_size, void* d_ws, size_t ws_size, hipStream_t stream) {
    static int grid = 0;
    if (!grid) {
        int dev = 0, cus = 0, per_cu = 0;
        hipGetDevice(&dev); hipDeviceGetAttribute(&cus, hipDeviceAttributeMultiprocessorCount, dev);
        if (hipFuncSetAttribute((const void*)fwd_kernel, hipFuncAttributeMaxDynamicSharedMemorySize, LDS_BYTES) != hipSuccess) fprintf(stderr, "kernel_launch: hipFuncSetAttribute failed\n");
        if (hipOccupancyMaxActiveBlocksPerMultiprocessor(&per_cu, (const void*)fwd_kernel, NTHREADS, LDS_BYTES) != hipSuccess || per_cu < 1) { fprintf(stderr, "kernel_launch: occupancy query says %d\n", per_cu); per_cu = 1; }
        grid = cus > 0 ? cus : 256;
        if (n_in != 19 || ws_size < WS_END) fprintf(stderr, "kernel_launch: unexpected n_in %d / ws_size %zu (need %zu)\n", n_in, ws_size, (size_t)WS_END);
    }
    Params p{};
    for (int i = 0; i < 19; ++i) p.in[i] = (const float*)d_in[i];
    p.out = (float*)d_out; p.ws = (unsigned char*)d_ws;
#if MK_ONE_LAUNCH
    p.ph_lo = 0; p.ph_hi = N_PHASES;
    void* args[] = {&p};
    hipError_t e = hipLaunchCooperativeKernel((const void*)fwd_kernel, dim3(grid), dim3(NTHREADS), args, LDS_BYTES, stream);
    if (e != hipSuccess) fprintf(stderr, "kernel_launch: cooperative launch failed: %s (grid %d)\n", hipGetErrorString(e), grid);
#else
    for (int ph = 0; ph < N_PHASES; ++ph) { p.ph_lo = ph; p.ph_hi = ph + 1; hipLaunchKernelGGL(fwd_kernel, dim3(grid), dim3(NTHREADS), LDS_BYTES, stream, p); }
#endif
}
```

```cpp
#include <hip/hip_runtime.h>
#include <hip/hip_cooperative_groups.h>
#include <cstdio>
#include <cstdint>
namespace cg = cooperative_groups;
#ifndef MK_ONE_LAUNCH
#define MK_ONE_LAUNCH 1
#endif
namespace pg8 {
#define PG8_LAS __attribute__((address_space(3)))
typedef unsigned short bf16_t;
typedef short bf16x8 __attribute__((ext_vector_type(8)));
typedef float f32x4 __attribute__((ext_vector_type(4)));
typedef unsigned u32x4 __attribute__((ext_vector_type(4)));
constexpr int BM = 256, BK = 64, HALF = 128, HTB = HALF * BK * 2  , STAGE_BYTES = 8 * HTB, NXCD = 8, WGM = 8;

__host__ __device__ __forceinline__ int lds_byte(int r, int c) { const int st = (r >> 4) * 2 + (c >> 5), rr = r & 15, cc = c & 31, ob = rr * 64 + cc * 2; return st * 1024 + (ob ^ (((ob >> 9) & 1) << 5)); }
__host__ __device__ __forceinline__ void stage_rc(int b, int& R, int& C) { const int st = b / 1024, sb = b % 1024, swz = sb ^ (((sb >> 9) & 1) << 5); R = (st >> 1) * 16 + swz / 64; C = (st & 1) * 32 + (swz % 64) / 2; }
__host__ __device__ __forceinline__ int perm32(int rho) { const int n = rho >> 4, i = rho & 15; return 8 * (i >> 2) + 4 * n + (i & 3); }

struct Unit { int pm, pn; };
struct Gemm { const bf16_t* A; const bf16_t* Bt; int M, N, K; };

struct StaticOrder {
    int nM, nN, nwg, G, c;
    __host__ __device__ void init(int M, int N, int G_, int c_) { nM = M / BM; nN = N / BM; nwg = nM * nN; G = G_; c = c_; }
    __host__ __device__ bool next(int i, Unit& u) const {
        const long L = (long)i * G + c; if (L >= nwg) return false;
        int wgid = (int)L; { const int q = nwg / NXCD, r = nwg % NXCD, xcd = wgid % NXCD, off = wgid / NXCD; wgid = (xcd < r ? xcd * (q + 1) : r * (q + 1) + (xcd - r) * q) + off; }
        const int nig = WGM * nN, gid = wgid / nig, fm = gid * WGM, gsz = (nM - fm) < WGM ? (nM - fm) : WGM;
        u.pm = fm + ((wgid % nig) % gsz); u.pn = (wgid % nig) / gsz; return true;
    }
    __device__ __forceinline__ void a_ready(const Unit&) const {}
    __device__ __forceinline__ void done(const Unit&) const {}
};
__device__ __forceinline__ unsigned cvt_pk_bf16(float lo, float hi) { unsigned r; asm volatile("v_cvt_pk_bf16_f32 %0, %1, %2" : "=v"(r) : "v"(lo), "v"(hi)); return r; }
typedef float f32x2c_t __attribute__((ext_vector_type(2))); typedef __bf16 bf16x2c_t __attribute__((ext_vector_type(2)));
__device__ __forceinline__ unsigned cvt_pk_native(float lo, float hi) { const f32x2c_t v = {lo, hi}; const bf16x2c_t b = __builtin_convertvector(v, bf16x2c_t); return __builtin_bit_cast(unsigned, b); }
__device__ __forceinline__ u32x4 pack8(const f32x4 v0, const f32x4 v1) { u32x4 w; w.x = cvt_pk_native(v0[0], v0[1]); w.y = cvt_pk_native(v0[2], v0[3]); w.z = cvt_pk_native(v1[0], v1[1]); w.w = cvt_pk_native(v1[2], v1[3]); return w; }
struct EpiIn {
    static constexpr bool PERM = true, AFTER_DRAIN = false;
    bf16_t *BG, *U, *ZF;
    __device__ __forceinline__ void operator()(const f32x4 (&acc)[2][2][4][2], const Unit& u, int wr, int wc, int fr, int fq) const {
        const int row0 = u.pm * BM + wr * 64 + fr, cl = wc * 32 + 8 * fq;
        if (u.pn < 2) {
#pragma unroll
            for (int ai = 0; ai < 2; ++ai)
#pragma unroll
                for (int m = 0; m < 4; ++m) { bf16_t* rowp = BG + (size_t)(row0 + ai * HALF + m * 16) * 512 + u.pn * 256 + cl;
#pragma unroll
                    for (int bj = 0; bj < 2; ++bj) *(u32x4*)(rowp + bj * HALF) = pack8(acc[ai][bj][m][0], acc[ai][bj][m][1]); }
        } else if (u.pn < 6) {
#pragma unroll
            for (int ai = 0; ai < 2; ++ai)
#pragma unroll
                for (int m = 0; m < 4; ++m) { bf16_t* rowp = U + (size_t)(row0 + ai * HALF + m * 16) * 512 + (u.pn - 2) * 128 + cl;
                    *(u32x4*)rowp = pack8(acc[ai][0][m][0] * acc[ai][1][m][0], acc[ai][0][m][1] * acc[ai][1][m][1]); }
        } else {
#pragma unroll
            for (int ai = 0; ai < 2; ++ai)
#pragma unroll
                for (int m = 0; m < 4; ++m) { bf16_t* rowp = ZF + (size_t)(row0 + ai * HALF + m * 16) * 512 + (u.pn - 6) * 256 + cl;
#pragma unroll
                    for (int bj = 0; bj < 2; ++bj) *(u32x4*)(rowp + bj * HALF) = pack8(acc[ai][bj][m][0], acc[ai][bj][m][1]); }
        }
    }
};
struct EpiOS {
    static constexpr bool PERM = true, AFTER_DRAIN = false;
    bf16_t* O; float* stats;
    __device__ __forceinline__ void operator()(const f32x4 (&acc)[2][2][4][2], const Unit& u, int wr, int wc, int fr, int fq) const {
        const int row0 = u.pm * BM + wr * 64 + fr, cl = wc * 32 + 8 * fq;
#pragma unroll
        for (int ai = 0; ai < 2; ++ai)
#pragma unroll
            for (int m = 0; m < 4; ++m) { const int row = row0 + ai * HALF + m * 16; bf16_t* rowp = O + (size_t)row * 1024 + u.pn * 256 + cl; float s = 0.f;
#pragma unroll
                for (int bj = 0; bj < 2; ++bj) { const f32x4 a = acc[ai][bj][m][0], b = acc[ai][bj][m][1];
                    s += (a[0] * a[0] + a[1] * a[1]) + (a[2] * a[2] + a[3] * a[3]) + (b[0] * b[0] + b[1] * b[1]) + (b[2] * b[2] + b[3] * b[3]);
                    *(u32x4*)(rowp + bj * HALF) = pack8(a, b); }
                { const int ln = fq * 16 + fr;
                  s += __int_as_float(__builtin_amdgcn_ds_bpermute((ln ^ 16) << 2, __float_as_int(s))); s += __int_as_float(__builtin_amdgcn_ds_bpermute((ln ^ 32) << 2, __float_as_int(s))); }
                if (fq == 0) stats[(size_t)row * 16 + u.pn * 4 + wc] = s; }
    }
};
__device__ __forceinline__ float silu_f(float g) { return g * __builtin_amdgcn_rcpf(1.0f + __expf(-g)); }
typedef float f32x2e __attribute__((ext_vector_type(2)));
__device__ __forceinline__ f32x2e silu_mul2(f32x2e g, f32x2e u) {
    f32x2e t = g * (-1.4426950408889634f);
    t.x = __builtin_fminf(t.x, 60.0f); t.y = __builtin_fminf(t.y, 60.0f);
    f32x2e p; p.x = __builtin_amdgcn_exp2f(t.x); p.y = __builtin_amdgcn_exp2f(t.y);
    p = p + 1.0f;
    const float r = __builtin_amdgcn_rcpf(p.x * p.y);
    const f32x2e sw = {p.y, p.x};
    return (g * u) * (sw * r);
}
__device__ __forceinline__ f32x4 silu_mul4(const f32x4 g, const f32x4 u) {
    const f32x2e a = silu_mul2((f32x2e){g[0], g[1]}, (f32x2e){u[0], u[1]}), b = silu_mul2((f32x2e){g[2], g[3]}, (f32x2e){u[2], u[3]});
    return (f32x4){a.x, a.y, b.x, b.y};
}
struct EpiAct {
    static constexpr bool PERM = true, AFTER_DRAIN = false;
    bf16_t* ACT;
    __device__ __forceinline__ void operator()(const f32x4 (&acc)[2][2][4][2], const Unit& u, int wr, int wc, int fr, int fq) const {
        const int row0 = u.pm * BM + wr * 64 + fr, cl = wc * 32 + 8 * fq;
#pragma unroll
        for (int ai = 0; ai < 2; ++ai)
#pragma unroll
            for (int m = 0; m < 4; ++m) { bf16_t* rowp = ACT + (size_t)(row0 + ai * HALF + m * 16) * 2816 + u.pn * 128 + cl;
                const f32x4 v0 = silu_mul4(acc[ai][0][m][0], acc[ai][1][m][0]), v1 = silu_mul4(acc[ai][0][m][1], acc[ai][1][m][1]);
                *(u32x4*)rowp = pack8(v0, v1); }
    }
};
struct EpiNull {
    static constexpr bool PERM = true, AFTER_DRAIN = false;
    float* dummy;
    __device__ __forceinline__ void operator()(const f32x4 (&acc)[2][2][4][2], const Unit& u, int wr, int wc, int fr, int fq) const {
        float s = 0.f;
#pragma unroll
        for (int ai = 0; ai < 2; ++ai)
#pragma unroll
            for (int bj = 0; bj < 2; ++bj)
#pragma unroll
                for (int m = 0; m < 4; ++m)
#pragma unroll
                    for (int n = 0; n < 2; ++n) s += (acc[ai][bj][m][n][0] + acc[ai][bj][m][n][1]) + (acc[ai][bj][m][n][2] + acc[ai][bj][m][n][3]);
        if (s == 1.2345678e33f) dummy[u.pm * 256 + fr] = s;
    }
};
template <class Epi, class Sched, bool ALIGN_EPI = false, bool SP2 = false>
__device__ __forceinline__ void gemm_phase(PG8_LAS unsigned char* lds, const Gemm g, const Sched& S, const Epi& E, const int wv_s) {
    int tid_; asm volatile("v_mbcnt_lo_u32_b32 %0, -1, 0\n\tv_mbcnt_hi_u32_b32 %0, -1, %0" : "=v"(tid_)); tid_ += wv_s * 64;
    const int tid = tid_, wid = __builtin_amdgcn_readfirstlane(tid >> 6), lane = tid & 63, wr = wid >> 2, wc = wid & 3, fr = lane & 15, fq = lane >> 4;
    const int K = g.K, nt = K / BK;
    unsigned voffA[2], voffB[2];
#pragma unroll
    for (int i = 0; i < 2; ++i) { int R, C; stage_rc(tid * 16 + i * 8192, R, C); const int Rb = Epi::PERM ? ((R & ~31) + perm32(R & 31)) : R;
        voffA[i] = (unsigned)(R * K + C) * 2u; voffB[i] = (unsigned)(Rb * K + C) * 2u; }
    const size_t kstep = (size_t)(BK * 2);
    const size_t hstep = (size_t)HALF * K * 2;
    const size_t tstep = 2 * hstep;
    const unsigned ldsw = (unsigned)wid * 1024u;
    const int aoff = lds_byte(wr * 64 + fr, fq * 8), boff = lds_byte(wc * 32 + fr, fq * 8);
#define PG8_SA(b, h) (((b) * 2 + (h)) * HTB)
#define PG8_SB(b, h) ((4 + (b) * 2 + (h)) * HTB)
#define PG8_STAGE(bufoff, gbase, voff) do { _Pragma("unroll") for (int _i = 0; _i < 2; ++_i) \
        __builtin_amdgcn_global_load_lds((const unsigned*)((const char*)(gbase) + (voff)[_i]), (PG8_LAS unsigned*)(lds + (bufoff) + ldsw + _i * 8192), 16, 0, 0); } while (0)
#define PG8_LDA(dst, b, h) do { _Pragma("unroll") for (int m = 0; m < 4; ++m) _Pragma("unroll") for (int k = 0; k < 2; ++k) dst[m][k] = *(const PG8_LAS bf16x8*)(lds + PG8_SA(b, h) + aoff + m * 2048 + k * 1024); } while (0)
#define PG8_LDB(dst, b, h) do { _Pragma("unroll") for (int n = 0; n < 2; ++n) _Pragma("unroll") for (int k = 0; k < 2; ++k) dst[n][k] = *(const PG8_LAS bf16x8*)(lds + PG8_SB(b, h) + boff + n * 2048 + k * 1024); } while (0)
#define PG8_MMA(ai, bj, At, Bt) do { __builtin_amdgcn_s_setprio(1); _Pragma("unroll") for (int m = 0; m < 4; ++m) _Pragma("unroll") for (int n = 0; n < 2; ++n) _Pragma("unroll") for (int k = 0; k < 2; ++k) \
        acc[ai][bj][m][n] = __builtin_amdgcn_mfma_f32_16x16x32_bf16(Bt[n][k], At[m][k], acc[ai][bj][m][n], 0, 0, 0); __builtin_amdgcn_s_setprio(0); } while (0)
#define PG8_WAIT_V(n) asm volatile("s_waitcnt vmcnt(" #n ")" ::: "memory")
#define PG8_WAIT_L(n) asm volatile("s_waitcnt lgkmcnt(" #n ")" ::: "memory")
#define PG8_BAR __builtin_amdgcn_s_barrier()
#define PG8_SCHED __builtin_amdgcn_sched_barrier(0)
    Unit cur, nxt; int ui = 0;
    if (!S.next(0, cur)) return;
    f32x4 acc[2][2][4][2];
#pragma unroll
    for (int a = 0; a < 2; ++a)
#pragma unroll
        for (int b = 0; b < 2; ++b)
#pragma unroll
            for (int m = 0; m < 4; ++m)
#pragma unroll
                for (int n = 0; n < 2; ++n) acc[a][b][m][n] = (f32x4){0.f, 0.f, 0.f, 0.f};
    bf16x8 At[4][2], B0[2][2], B1[2][2];
    const char* cA = (const char*)g.A + (size_t)cur.pm * tstep; const char* cB = (const char*)g.Bt + (size_t)cur.pn * tstep;
    S.a_ready(cur);
    if constexpr (SP2) {
        PG8_STAGE(PG8_SB(0, 0), cB, voffB); PG8_STAGE(PG8_SB(0, 1), cB + hstep, voffB); PG8_STAGE(PG8_SA(0, 0), cA, voffA); PG8_STAGE(PG8_SA(0, 1), cA + hstep, voffA);
        if (wr == 1) PG8_BAR;
        PG8_WAIT_V(2); PG8_BAR;
        PG8_STAGE(PG8_SB(1, 0), cB + kstep, voffB); PG8_STAGE(PG8_SA(1, 0), cA + kstep, voffA); PG8_STAGE(PG8_SB(1, 1), cB + hstep + kstep, voffB);
        PG8_WAIT_V(6); PG8_BAR;
    } else {
        PG8_STAGE(PG8_SB(0, 0), cB, voffB); PG8_STAGE(PG8_SA(0, 0), cA, voffA); PG8_STAGE(PG8_SB(0, 1), cB + hstep, voffB); PG8_STAGE(PG8_SA(0, 1), cA + hstep, voffA);
        if (wr == 1) PG8_BAR;
        PG8_WAIT_V(4); PG8_BAR;
        PG8_STAGE(PG8_SB(1, 0), cB + kstep, voffB); PG8_STAGE(PG8_SA(1, 0), cA + kstep, voffA); PG8_STAGE(PG8_SB(1, 1), cB + hstep + kstep, voffB);
        PG8_WAIT_V(6); PG8_BAR;
    }
    for (;;) {
        const bool has_next = S.next(ui + 1, nxt);
        const char* nA = has_next ? (const char*)g.A + (size_t)nxt.pm * tstep : cA; const char* nB = has_next ? (const char*)g.Bt + (size_t)nxt.pn * tstep : cB;
        for (int t = 0; t < nt; t += 2) {
            const bool last = (t == nt - 2);
            const char* a1 = cA + (size_t)(t + 1) * kstep;
            const char* a2 = last ? nA : cA + (size_t)(t + 2) * kstep; const char* b2 = last ? nB : cB + (size_t)(t + 2) * kstep;
            const char* a3 = a2 + kstep; const char* b3 = b2 + kstep;
            if (last && has_next) S.a_ready(nxt);
            if constexpr (SP2) {
            PG8_LDB(B0, 0, 0); PG8_LDB(B1, 0, 1); PG8_SCHED; PG8_LDA(At, 0, 0); PG8_STAGE(PG8_SA(1, 1), a1 + hstep, voffA);
            PG8_WAIT_V(8); PG8_WAIT_L(0); PG8_BAR; PG8_MMA(0, 0, At, B0); PG8_MMA(0, 1, At, B1); PG8_BAR; PG8_SCHED;
            PG8_LDA(At, 0, 1); PG8_STAGE(PG8_SB(0, 0), b2, voffB); PG8_STAGE(PG8_SB(0, 1), b2 + hstep, voffB); PG8_STAGE(PG8_SA(0, 0), a2, voffA);
            PG8_WAIT_V(8); PG8_WAIT_L(0); PG8_BAR; PG8_MMA(1, 0, At, B0); PG8_MMA(1, 1, At, B1); PG8_BAR; PG8_SCHED;
            PG8_LDB(B0, 1, 0); PG8_LDB(B1, 1, 1); PG8_SCHED; PG8_LDA(At, 1, 0); PG8_STAGE(PG8_SA(0, 1), a2 + hstep, voffA);
            PG8_WAIT_V(8); PG8_WAIT_L(0); PG8_BAR; PG8_MMA(0, 0, At, B0); PG8_MMA(0, 1, At, B1); PG8_BAR; PG8_SCHED;
            PG8_LDA(At, 1, 1); PG8_STAGE(PG8_SB(1, 0), b3, voffB); PG8_STAGE(PG8_SB(1, 1), b3 + hstep, voffB); PG8_STAGE(PG8_SA(1, 0), a3, voffA);
            PG8_WAIT_V(8); PG8_WAIT_L(0); PG8_BAR; PG8_MMA(1, 0, At, B0); PG8_MMA(1, 1, At, B1); PG8_BAR; PG8_SCHED;
            } else {
            PG8_LDB(B0, 0, 0); PG8_SCHED; PG8_LDA(At, 0, 0); PG8_STAGE(PG8_SA(1, 1), a1 + hstep, voffA);
            PG8_WAIT_L(8); PG8_BAR; PG8_WAIT_L(0); PG8_MMA(0, 0, At, B0); PG8_BAR; PG8_SCHED;
            PG8_LDB(B1, 0, 1); PG8_STAGE(PG8_SB(0, 0), b2, voffB);
            PG8_BAR; PG8_WAIT_L(0); PG8_MMA(0, 1, At, B1); PG8_BAR;
            PG8_LDA(At, 0, 1); PG8_STAGE(PG8_SA(0, 0), a2, voffA);
            PG8_BAR; PG8_WAIT_L(0); PG8_MMA(1, 0, At, B0); PG8_BAR; PG8_SCHED;
            PG8_STAGE(PG8_SB(0, 1), b2 + hstep, voffB);
            PG8_WAIT_V(6); PG8_BAR; PG8_MMA(1, 1, At, B1); PG8_BAR;
            PG8_LDB(B0, 1, 0); PG8_SCHED; PG8_LDA(At, 1, 0); PG8_STAGE(PG8_SA(0, 1), a2 + hstep, voffA);
            PG8_WAIT_L(8); PG8_BAR; PG8_WAIT_L(0); PG8_MMA(0, 0, At, B0); PG8_BAR; PG8_SCHED;
            PG8_LDB(B1, 1, 1); PG8_STAGE(PG8_SB(1, 0), b3, voffB);
            PG8_BAR; PG8_WAIT_L(0); PG8_MMA(0, 1, At, B1); PG8_BAR;
            PG8_LDA(At, 1, 1); PG8_STAGE(PG8_SA(1, 0), a3, voffA);
            PG8_BAR; PG8_WAIT_L(0); PG8_MMA(1, 0, At, B0); PG8_BAR; PG8_SCHED;
            PG8_STAGE(PG8_SB(1, 1), b3 + hstep, voffB);
            PG8_WAIT_V(6); PG8_BAR; PG8_MMA(1, 1, At, B1); PG8_BAR;
            }
        }
        if constexpr (ALIGN_EPI) { if (wr == 0) PG8_BAR; }
        if constexpr (!Epi::AFTER_DRAIN) { E(acc, cur, wr, wc, fr, fq); S.done(cur); }
        if (!has_next) break;
#pragma unroll
        for (int a = 0; a < 2; ++a)
#pragma unroll
            for (int b = 0; b < 2; ++b)
#pragma unroll
                for (int m = 0; m < 4; ++m)
#pragma unroll
                    for (int n = 0; n < 2; ++n) acc[a][b][m][n] = (f32x4){0.f, 0.f, 0.f, 0.f};
        cur = nxt; cA = nA; cB = nB; ++ui;
        if constexpr (ALIGN_EPI) { if (wr == 1) PG8_BAR; }
    }
    PG8_WAIT_V(0);
    if constexpr (!ALIGN_EPI) { if (wr == 0) PG8_BAR; }
    PG8_BAR;
    if constexpr (Epi::AFTER_DRAIN) { E.fused(acc, cur, wr, wc, fr, fq, lds, wid, lane); S.done(cur); }
#undef PG8_SA
#undef PG8_SB
#undef PG8_STAGE
#undef PG8_LDA
#undef PG8_LDB
#undef PG8_MMA
#undef PG8_WAIT_V
#undef PG8_WAIT_L
#undef PG8_BAR
#undef PG8_SCHED
}
}
#define LAS __attribute__((address_space(3)))
typedef unsigned short bf16;
typedef float f32x4 __attribute__((ext_vector_type(4)));
typedef unsigned v4u __attribute__((ext_vector_type(4)));
typedef unsigned v2u __attribute__((ext_vector_type(2)));
constexpr int D = 1024, M_P = 16384, M_S = 65536, M = M_P + M_S, NB = 24, DEPTH = 4;
constexpr int N_IN = 2048, N_GU = 5632, DFF = 2816;
constexpr float EPS = 1e-6f;
constexpr int NWAVES = 8, NTHREADS = 512;
constexpr int LDS_BYTES = 147456 + 2048;
constexpr int MISC_OFF = 147456;
constexpr size_t WS_WIN = 0;
constexpr size_t WS_WOUT = WS_WIN + (size_t)DEPTH * N_IN * D * 2;
constexpr size_t WS_WGU = WS_WOUT + (size_t)DEPTH * D * D * 2;
constexpr size_t WS_WDN = WS_WGU + (size_t)DEPTH * N_GU * D * 2;
constexpr size_t WS_MOD = WS_WDN + (size_t)DEPTH * D * DFF * 2;
constexpr size_t WS_TW4 = WS_MOD + (size_t)DEPTH * NB * 6 * D * 4;
constexpr size_t WS_TW2 = WS_TW4 + 4096 * 8;
constexpr size_t WS_STATS = WS_TW2 + 2048 * 8;
constexpr size_t WS_RA = WS_STATS + (size_t)M * 16 * 4;
constexpr size_t WS_RB = WS_RA + (size_t)M * D * 2;
constexpr size_t WS_BAR = WS_RB + (size_t)M * DFF * 2 + (size_t)M * D * 2;
constexpr size_t WS_XB = WS_RB + (size_t)M * DFF * 2;
constexpr size_t WS_CNT = WS_BAR + 16384;
constexpr size_t WS_SLOT = WS_CNT + (size_t)16 * 320 * 256;
constexpr size_t WS_END = WS_SLOT + (size_t)16 * M * 4 * 4;
constexpr float C64[64] = {1.000000000e+00f, 9.951847267e-01f, 9.807852804e-01f, 9.569403357e-01f, 9.238795325e-01f, 8.819212643e-01f, 8.314696123e-01f, 7.730104534e-01f, 7.071067812e-01f, 6.343932842e-01f, 5.555702330e-01f, 4.713967368e-01f, 3.826834324e-01f, 2.902846773e-01f, 1.950903220e-01f, 9.801714033e-02f, 6.123233996e-17f, -9.801714033e-02f, -1.950903220e-01f, -2.902846773e-01f, -3.826834324e-01f, -4.713967368e-01f, -5.555702330e-01f, -6.343932842e-01f, -7.071067812e-01f, -7.730104534e-01f, -8.314696123e-01f, -8.819212643e-01f, -9.238795325e-01f, -9.569403357e-01f, -9.807852804e-01f, -9.951847267e-01f, -1.000000000e+00f, -9.951847267e-01f, -9.807852804e-01f, -9.569403357e-01f, -9.238795325e-01f, -8.819212643e-01f, -8.314696123e-01f, -7.730104534e-01f, -7.071067812e-01f, -6.343932842e-01f, -5.555702330e-01f, -4.713967368e-01f, -3.826834324e-01f, -2.902846773e-01f, -1.950903220e-01f, -9.801714033e-02f, -1.836970199e-16f, 9.801714033e-02f, 1.950903220e-01f, 2.902846773e-01f, 3.826834324e-01f, 4.713967368e-01f, 5.555702330e-01f, 6.343932842e-01f, 7.071067812e-01f, 7.730104534e-01f, 8.314696123e-01f, 8.819212643e-01f, 9.238795325e-01f, 9.569403357e-01f, 9.807852804e-01f, 9.951847267e-01f};
constexpr float S64[64] = {0.000000000e+00f, 9.801714033e-02f, 1.950903220e-01f, 2.902846773e-01f, 3.826834324e-01f, 4.713967368e-01f, 5.555702330e-01f, 6.343932842e-01f, 7.071067812e-01f, 7.730104534e-01f, 8.314696123e-01f, 8.819212643e-01f, 9.238795325e-01f, 9.569403357e-01f, 9.807852804e-01f, 9.951847267e-01f, 1.000000000e+00f, 9.951847267e-01f, 9.807852804e-01f, 9.569403357e-01f, 9.238795325e-01f, 8.819212643e-01f, 8.314696123e-01f, 7.730104534e-01f, 7.071067812e-01f, 6.343932842e-01f, 5.555702330e-01f, 4.713967368e-01f, 3.826834324e-01f, 2.902846773e-01f, 1.950903220e-01f, 9.801714033e-02f, 1.224646799e-16f, -9.801714033e-02f, -1.950903220e-01f, -2.902846773e-01f, -3.826834324e-01f, -4.713967368e-01f, -5.555702330e-01f, -6.343932842e-01f, -7.071067812e-01f, -7.730104534e-01f, -8.314696123e-01f, -8.819212643e-01f, -9.238795325e-01f, -9.569403357e-01f, -9.807852804e-01f, -9.951847267e-01f, -1.000000000e+00f, -9.951847267e-01f, -9.807852804e-01f, -9.569403357e-01f, -9.238795325e-01f, -8.819212643e-01f, -8.314696123e-01f, -7.730104534e-01f, -7.071067812e-01f, -6.343932842e-01f, -5.555702330e-01f, -4.713967368e-01f, -3.826834324e-01f, -2.902846773e-01f, -1.950903220e-01f, -9.801714033e-02f};


__device__ __forceinline__ float bf_lo(unsigned v) { return __uint_as_float(v << 16); }
__device__ __forceinline__ float bf_hi(unsigned v) { return __uint_as_float(v & 0xffff0000u); }
__device__ __forceinline__ unsigned pk2(float lo, float hi) { return pg8::cvt_pk_bf16(lo, hi); }
typedef float f32x2_t __attribute__((ext_vector_type(2)));
typedef __bf16 bf16x2_t __attribute__((ext_vector_type(2)));
__device__ __forceinline__ unsigned cvtpk_native(float lo, float hi) { const f32x2_t v = {lo, hi}; const bf16x2_t b = __builtin_convertvector(v, bf16x2_t); return __builtin_bit_cast(unsigned, b); }
__device__ __forceinline__ int hw_tid(int wv_s) { int l; asm volatile("v_mbcnt_lo_u32_b32 %0, -1, 0\n\tv_mbcnt_hi_u32_b32 %0, -1, %0" : "=v"(l)); return wv_s * 64 + l; }
__device__ __forceinline__ float wave_sum(float v) {
#pragma unroll
    for (int o = 1; o < 64; o <<= 1) v += __shfl_xor(v, o);
    return v;
}
template <int CTRL, int RM> __device__ __forceinline__ float dppf(float v) { return __int_as_float(__builtin_amdgcn_update_dpp(0, __float_as_int(v), CTRL, RM, 0xF, false)); }
__device__ __forceinline__ float wave_sum_dpp(float v) {
    v += dppf<0x128, 0xF>(v); v += dppf<0x124, 0xF>(v); v += dppf<0x122, 0xF>(v); v += dppf<0x121, 0xF>(v);
    v += dppf<0x142, 0xA>(v); v += dppf<0x143, 0xC>(v);
    return __int_as_float(__builtin_amdgcn_readlane(__float_as_int(v), 63));
}
__device__ __forceinline__ int row_batch(int r) { return r < M_P ? (r >> 11) : 8 + ((r - M_P) >> 12); }

struct Params { const float* in[19]; float* out; unsigned char* ws; int ph_lo, ph_hi; };

template <int N> __device__ __forceinline__ void fft_dif(float (&re)[N], float (&im)[N]) {
#pragma unroll
    for (int half = N / 2; half >= 1; half >>= 1) {
        const int step = 32 / half;
#pragma unroll
        for (int blk = 0; blk < N; blk += 2 * half) {
#pragma unroll
            for (int j = 0; j < half; ++j) {
                const int i0 = blk + j, i1 = i0 + half, ti = j * step;
                const float ar = re[i0], ai = im[i0], br = re[i1], bi = im[i1];
                re[i0] = ar + br; im[i0] = ai + bi;
                const float dr = ar - br, di = ai - bi;
                if (ti == 0) { re[i1] = dr; im[i1] = di; }
                else if (ti == 16) { re[i1] = di; im[i1] = -dr; }
                else { const float c = C64[ti], s = S64[ti]; re[i1] = dr * c + di * s; im[i1] = di * c - dr * s; }
            }
        }
    }
}
template <int N> __device__ __forceinline__ constexpr int brev(int i) { int r = 0; for (int b = 1, o = N >> 1; b < N; b <<= 1, o >>= 1) if (i & b) r |= o; return r; }

__device__ __forceinline__ void tile_writeout(int K, bf16* WT, int k0, int n0, LAS float* scr, int lane) {
    asm volatile("s_waitcnt lgkmcnt(0)" ::: "memory");
    const int c = lane & 7;
#pragma unroll
    for (int j = 0; j < 4; ++j) { const int n = (lane >> 3) + 8 * j; const LAS float* s = scr + (8 * c) * 33 + n;
        v4u o; o.x = pk2(s[0 * 33], s[1 * 33]); o.y = pk2(s[2 * 33], s[3 * 33]); o.z = pk2(s[4 * 33], s[5 * 33]); o.w = pk2(s[6 * 33], s[7 * 33]);
        *(v4u*)(WT + (size_t)(n0 + n) * K + k0 + 8 * c) = o; }
    asm volatile("s_waitcnt lgkmcnt(0)" ::: "memory");
}
template <class Src> __device__ __forceinline__ void transpose_item(const Src& src, int K, bf16* WT, int k0, int n0, LAS float* scr, int lane) {
    f32x4 v[8];
#pragma unroll
    for (int i = 0; i < 8; ++i) v[i] = src.ld4(k0 + 8 * i + (lane >> 3), n0 + 4 * (lane & 7));
#pragma unroll
    for (int i = 0; i < 8; ++i) { LAS float* d = scr + (8 * i + (lane >> 3)) * 33 + 4 * (lane & 7); d[0] = v[i][0]; d[1] = v[i][1]; d[2] = v[i][2]; d[3] = v[i][3]; }
    tile_writeout(K, WT, k0, n0, scr, lane);
}
__device__ __forceinline__ void fold_item(const float* W  , const LAS float* T, bf16* WT, int k0, int n0, LAS float* scr, int lane) {
    const int q = n0 + (lane & 31) - 1536, m = q >> 1, part = q & 1, g = m >> 6, mm = m & 63;
    float Tr[64];
#pragma unroll
    for (int j = 0; j < 64; ++j) Tr[j] = T[64 * part + ((j * mm) & 63)];
#pragma unroll 2
    for (int i = 0; i < 32; ++i) { const int kk = 2 * i + (lane >> 5); const f32x4* f = (const f32x4*)(W + (size_t)(k0 + kk) * 2048 + 1536 + 64 * g);
        float s0 = 0.f, s1 = 0.f;
#pragma unroll
        for (int jj = 0; jj < 16; jj += 2) { const f32x4 a = f[jj], b = f[jj + 1];
            s0 += (a[0] * Tr[4 * jj] + a[1] * Tr[4 * jj + 1]) + (a[2] * Tr[4 * jj + 2] + a[3] * Tr[4 * jj + 3]);
            s1 += (b[0] * Tr[4 * jj + 4] + b[1] * Tr[4 * jj + 5]) + (b[2] * Tr[4 * jj + 6] + b[3] * Tr[4 * jj + 7]); }
        scr[kk * 33 + (lane & 31)] = s0 + s1; }
    tile_writeout(D, WT, k0, n0, scr, lane);
}
struct SrcPlain { const float* W; int ldw; __device__ __forceinline__ float operator()(int k, int n) const { return W[(size_t)k * ldw + n]; }
    __device__ __forceinline__ f32x4 ld4(int k, int n) const { return *(const f32x4*)(W + (size_t)k * ldw + n); } };
struct SrcIn { const float* W; const LAS float* T;
    __device__ __forceinline__ float operator()(int k, int n) const {
        const float* wr = W + (size_t)k * 2048;
        if (n < 512) return wr[n];
        if (n < 1536) { const int tt = (n - 512) >> 8, c = (n - 512) & 255; return wr[c < 128 ? 512 + 128 * tt + c : 1024 + 128 * tt + (c - 128)]; }
        return wr[n]; }
    __device__ __forceinline__ f32x4 ld4(int k, int n) const {
        const float* wr = W + (size_t)k * 2048; int col = n;
        if (n >= 512 && n < 1536) { const int tt = (n - 512) >> 8, c = (n - 512) & 255; col = c < 128 ? 512 + 128 * tt + c : 1024 + 128 * tt + (c - 128); }
        return *(const f32x4*)(wr + col); } };
struct SrcInUnused { const float* W; __device__ __forceinline__ float f(int k, int n) const { const float* wr = W;
        return wr[n]; } };
struct SrcGU { const float *Wg, *Wu;
    __device__ __forceinline__ float operator()(int k, int n) const { const int j = n >> 8, c = n & 255; return c < 128 ? Wg[(size_t)k * DFF + 128 * j + c] : Wu[(size_t)k * DFF + 128 * j + (c - 128)]; }
    __device__ __forceinline__ f32x4 ld4(int k, int n) const { const int j = n >> 8, c = n & 255; return *(const f32x4*)(c < 128 ? Wg + (size_t)k * DFF + 128 * j + c : Wu + (size_t)k * DFF + 128 * j + (c - 128)); } };

__device__ __forceinline__ void p0_prep(const Params& P, LAS unsigned char* lds, const int wv_s) {
    int tid_ = hw_tid(wv_s); asm volatile("" : "+v"(tid_));
    const int tid = tid_, lane = tid & 63, wave = __builtin_amdgcn_readfirstlane(tid >> 6);
    unsigned char* ws = P.ws;
    LAS float* T = (LAS float*)(lds + MISC_OFF);
    LAS float* cact = (LAS float*)lds;
    LAS float* red = (LAS float*)(lds + 98304);
    if (tid < 64) { T[tid] = cospif((float)tid * (1.0f / 32.0f)); T[64 + tid] = sinpif((float)tid * (1.0f / 32.0f)); }
    for (int i = tid; i < NB * D; i += NTHREADS) { const int b = i >> 10, k = i & 1023; const float c = b < 8 ? P.in[2][b * D + k] : P.in[3][(b - 8) * D + k]; cact[i] = c / (1.0f + __expf(-c)); }
    __syncthreads();
    float* mod = (float*)(ws + WS_MOD);
    for (int item = blockIdx.x; item < DEPTH * 96; item += gridDim.x) {
        const int l = item / 96, n0 = (item % 96) * 64;
        const float* W = P.in[4] + (size_t)l * D * 6144 + n0 + lane;
        float acc[NB];
#pragma unroll
        for (int b = 0; b < NB; ++b) acc[b] = 0.f;
        const int k0 = wave * 128;
        for (int k = k0; k < k0 + 128; k += 8) {
            float w[8];
#pragma unroll
            for (int i = 0; i < 8; ++i) w[i] = W[(size_t)(k + i) * 6144];
#pragma unroll
            for (int b = 0; b < NB; ++b) { const f32x4 c4 = *(const LAS f32x4*)(cact + b * D + k), c5 = *(const LAS f32x4*)(cact + b * D + k + 4);
                acc[b] += ((c4[0] * w[0] + c4[1] * w[1]) + (c4[2] * w[2] + c4[3] * w[3])) + ((c5[0] * w[4] + c5[1] * w[5]) + (c5[2] * w[6] + c5[3] * w[7])); }
        }
#pragma unroll
        for (int b = 0; b < NB; ++b) red[(wave * NB + b) * 64 + lane] = acc[b];
        __syncthreads();
        for (int o = tid; o < NB * 64; o += NTHREADS) { const int b = o >> 6, n = o & 63; float s = 0.f;
#pragma unroll
            for (int w = 0; w < NWAVES; ++w) s += red[(w * NB + b) * 64 + n];
            mod[(size_t)(l * NB + b) * 6144 + n0 + n] = s + P.in[5][l * 6144 + n0 + n]; }
        __syncthreads();
    }
    if (blockIdx.x == 0) { unsigned* bw = (unsigned*)(ws + WS_BAR); for (int i = tid; i < 3456; i += NTHREADS) bw[i] = 0u; }
    { unsigned* cw = (unsigned*)(ws + WS_CNT); for (int i = blockIdx.x * NTHREADS + tid; i < 16 * 320; i += gridDim.x * NTHREADS) cw[64 * i] = 0u; }
    { float2* tw4 = (float2*)(ws + WS_TW4); float2* tw2 = (float2*)(ws + WS_TW2);
      for (int j = blockIdx.x * NTHREADS + tid; j < 4096 + 2048; j += gridDim.x * NTHREADS) {
          if (j < 4096) { float s, c; sincospif((float)j * (1.0f / 2048.0f), &s, &c); tw4[j] = make_float2(c, -s); }
          else { const int jj = j - 4096; float s, c; sincospif((float)jj * (1.0f / 1024.0f), &s, &c); tw2[jj] = make_float2(c, -s); } } }
}
__device__ __forceinline__ void p0_weights(const Params& P, LAS unsigned char* lds, const int wv_s) {
    int tid_ = hw_tid(wv_s); asm volatile("" : "+v"(tid_));
    const int tid = tid_, lane = tid & 63, wave = __builtin_amdgcn_readfirstlane(tid >> 6);
    unsigned char* ws = P.ws;
    LAS float* T = (LAS float*)(lds + MISC_OFF);
    if (tid < 64) { T[tid] = cospif((float)tid * (1.0f / 32.0f)); T[64 + tid] = sinpif((float)tid * (1.0f / 32.0f)); }
    __syncthreads();
    LAS float* scr = (LAS float*)(lds + wave * 8448);
    const int gw = blockIdx.x * NWAVES + wave, NGW = gridDim.x * NWAVES;
    constexpr int I_IN = 16 * 64, I_OUT = 16 * 32, I_GU = 16 * 176, I_DN = 44 * 32, I_L = I_IN + I_OUT + I_GU + I_DN;
    for (int it = gw; it < DEPTH * I_L; it += NGW) {
        const int l = it / I_L; int r = it % I_L;
        if (r < I_IN) { SrcIn s{P.in[8] + (size_t)l * D * 2048, T}; transpose_item(s, D, (bf16*)(ws + WS_WIN) + (size_t)l * N_IN * D, 64 * (r / 64), 32 * (r % 64), scr, lane); continue; } r -= I_IN;
        if (r < I_OUT) { SrcPlain s{P.in[13] + (size_t)l * D * D, D}; transpose_item(s, D, (bf16*)(ws + WS_WOUT) + (size_t)l * D * D, 64 * (r / 32), 32 * (r % 32), scr, lane); continue; } r -= I_OUT;
        if (r < I_GU) { SrcGU s{P.in[16] + (size_t)l * D * DFF, P.in[17] + (size_t)l * D * DFF}; transpose_item(s, D, (bf16*)(ws + WS_WGU) + (size_t)l * N_GU * D, 64 * (r / 176), 32 * (r % 176), scr, lane); continue; } r -= I_GU;
        { SrcPlain s{P.in[18] + (size_t)l * DFF * D, D}; transpose_item(s, DFF, (bf16*)(ws + WS_WDN) + (size_t)l * D * DFF, 64 * (r / 32), 32 * (r % 32), scr, lane); }
    }
}

#ifndef ROWCOOP
#define ROWCOOP 1
#endif
#ifndef NSETB
#define NSETB 2
#endif
#ifndef XBF16
#define XBF16 1
#endif
template <bool BR, bool DOH, bool LAST, bool FIRST> __device__ __forceinline__ void row_range(const Params& P, const int lane, const int r0, const int r1, const int step  , const float* gpost, const float* modg  ,
                                                                         const float* gpre, const float* modsh, const float* modsc) {
    bf16* RA = (bf16*)(P.ws + WS_RA); const float* stats = (const float*)(P.ws + WS_STATS);
    bf16* XB = (bf16*)(P.ws + WS_XB);
    constexpr bool XOUT32 = !XBF16 || LAST;
    constexpr bool XIN32 = !XBF16 || FIRST;
    constexpr int NSET = XIN32 ? 1 : NSETB;
    if (r0 >= r1) return;
    f32x4 gp[4], gq[4], gb[4], ga[4], sh[4];
#pragma unroll
    for (int j = 0; j < 4; ++j) { if (BR) gp[j] = ((const f32x4*)gpost)[lane + 64 * j]; if (DOH) gq[j] = ((const f32x4*)gpre)[lane + 64 * j]; }
    int gb_cur = -1;
    f32x4 xn[NSET][2][4]; v2u xbn[NSET][2][4]; v2u on[NSET][2][4]; float stn[NSET][2];
    auto xptr = [&](int row) -> const float* { return FIRST ? (row < M_P ? P.in[0] + (size_t)row * D : P.in[1] + (size_t)(row - M_P) * D) : P.out + (size_t)row * D; };
#define ROW_LOAD(s, q, row) do { if ((row) < r1) { const float* xr_ = xptr(row); _Pragma("unroll") for (int j = 0; j < 4; ++j) { \
        if (XIN32) xn[s][q][j] = __builtin_nontemporal_load(((const f32x4*)xr_) + lane + 64 * j); else xbn[s][q][j] = __builtin_nontemporal_load(((const v2u*)(XB + (size_t)(row) * D)) + lane + 64 * j); \
        if (BR) on[s][q][j] = __builtin_nontemporal_load(((const v2u*)(RA + (size_t)(row) * D)) + lane + 64 * j); } \
        if (BR) stn[s][q] = stats[(size_t)(row) * 16 + (lane & 15)]; } } while (0)
#pragma unroll
    for (int s = 0; s < NSET; ++s) { ROW_LOAD(s, 0, r0 + step * s); ROW_LOAD(s, 1, r0 + step * s + 1); }
    for (int rowg = r0; rowg < r1; rowg += step * NSET) {
#pragma unroll
        for (int s = 0; s < NSET; ++s) {
            const int rowp = rowg + step * s;
            f32x4 xc[2][4]; v2u oc[2][4]; float stc[2];
#pragma unroll
            for (int q = 0; q < 2; ++q) {
#pragma unroll
                for (int j = 0; j < 4; ++j) { if (XIN32) xc[q][j] = xn[s][q][j]; else xc[q][j] = (f32x4){bf_lo(xbn[s][q][j].x), bf_hi(xbn[s][q][j].x), bf_lo(xbn[s][q][j].y), bf_hi(xbn[s][q][j].y)}; if (BR) oc[q][j] = on[s][q][j]; }
                if (BR) stc[q] = stn[s][q]; }
            ROW_LOAD(s, 0, rowp + step * NSET); ROW_LOAD(s, 1, rowp + step * NSET + 1);
#pragma unroll
            for (int q = 0; q < 2; ++q) {
                const int row = rowp + q;
                if (row < r1) {
                    const int gbt = row_batch(row);
                    if (gbt != gb_cur) { gb_cur = gbt;
#pragma unroll
                        for (int j = 0; j < 4; ++j) { if (BR) gb[j] = ((const f32x4*)(modg + (size_t)gbt * 6144))[lane + 64 * j] * gp[j];
                            if (DOH) { sh[j] = ((const f32x4*)(modsh + (size_t)gbt * 6144))[lane + 64 * j]; ga[j] = (((const f32x4*)(modsc + (size_t)gbt * 6144))[lane + 64 * j] + 1.0f) * gq[j]; } } }
                    f32x4 x[4];
#pragma unroll
                    for (int j = 0; j < 4; ++j) x[j] = xc[q][j];
                    if (BR) {
                        float ss = stc[q]; ss += dppf<0x128, 0xF>(ss); ss += dppf<0x124, 0xF>(ss); ss += dppf<0x122, 0xF>(ss); ss += dppf<0x121, 0xF>(ss);
                        const float rinv = rsqrtf(ss * (1.0f / D) + EPS);
#pragma unroll
                        for (int j = 0; j < 4; ++j) {
                            const v2u o = oc[q][j];
                            x[j][0] += gb[j][0] * (bf_lo(o.x) * rinv); x[j][1] += gb[j][1] * (bf_hi(o.x) * rinv);
                            x[j][2] += gb[j][2] * (bf_lo(o.y) * rinv); x[j][3] += gb[j][3] * (bf_hi(o.y) * rinv);
                        }
#pragma unroll
                        for (int j = 0; j < 4; ++j) { if (XOUT32) __builtin_nontemporal_store(x[j], ((f32x4*)(P.out + (size_t)row * D)) + lane + 64 * j);
                            else { v2u w; w.x = pk2(x[j][0], x[j][1]); w.y = pk2(x[j][2], x[j][3]); ((v2u*)(XB + (size_t)row * D))[lane + 64 * j] = w;
                                   x[j] = (f32x4){bf_lo(w.x), bf_hi(w.x), bf_lo(w.y), bf_hi(w.y)}; } }
                    }
                    if (DOH) {
                        float s2 = 0.f;
#pragma unroll
                        for (int j = 0; j < 4; ++j) s2 += (x[j][0] * x[j][0] + x[j][1] * x[j][1]) + (x[j][2] * x[j][2] + x[j][3] * x[j][3]);
                        s2 = wave_sum_dpp(s2);
                        const float r2 = rsqrtf(s2 * (1.0f / D) + EPS);
#pragma unroll
                        for (int j = 0; j < 4; ++j) {
                            f32x4 h;
#pragma unroll
                            for (int e = 0; e < 4; ++e) h[e] = (x[j][e] * r2) * ga[j][e] + sh[j][e];
                            v2u w; w.x = pk2(h[0], h[1]); w.y = pk2(h[2], h[3]);
                            ((v2u*)(RA + (size_t)row * D))[lane + 64 * j] = w;
                        }
                    }
                }
            }
        }
    }
#undef ROW_LOAD
}
template <bool BR, bool DOH, bool LAST, bool FIRST> __device__ __forceinline__ void row_phase(const Params& P, const int wv_s, const float* gpost, const float* modg, const float* gpre, const float* modsh, const float* modsc) {
    int tid_ = hw_tid(wv_s); asm volatile("" : "+v"(tid_));
    const int lane = tid_ & 63, wave = __builtin_amdgcn_readfirstlane(tid_ >> 6);
    const int gw = blockIdx.x * NWAVES + wave, NGW = gridDim.x * NWAVES;
    const int rpw = (M + NGW - 1) / NGW, r0 = gw * rpw, r1 = (r0 + rpw < M) ? r0 + rpw : M;
#if ROWCOOP
    { const int rpb = rpw * NWAVES, b0 = blockIdx.x * rpb, b1 = (b0 + rpb < M) ? b0 + rpb : M;
      row_range<BR, DOH, LAST, FIRST>(P, lane, b0 + 2 * wave, b1, 2 * NWAVES, gpost, modg, gpre, modsh, modsc); }
#else
    row_range<BR, DOH, LAST, FIRST>(P, lane, r0, r1, 2, gpost, modg, gpre, modsh, modsc);
#endif
}
__device__ __forceinline__ unsigned gload_row(const void* rowp  , unsigned voff) { unsigned v; asm volatile("global_load_dword %0, %1, %2" : "=v"(v) : "v"(voff), "s"(rowp) : "memory"); return v; }
#define TIE16(a, o) asm volatile("" : "+v"(a[o + 0]), "+v"(a[o + 1]), "+v"(a[o + 2]), "+v"(a[o + 3]), "+v"(a[o + 4]), "+v"(a[o + 5]), "+v"(a[o + 6]), "+v"(a[o + 7]), \
                                      "+v"(a[o + 8]), "+v"(a[o + 9]), "+v"(a[o + 10]), "+v"(a[o + 11]), "+v"(a[o + 12]), "+v"(a[o + 13]), "+v"(a[o + 14]), "+v"(a[o + 15]))
__device__ __forceinline__ void f1_phase(const Params& P, LAS unsigned char* lds, const int wv_s) {
    typedef short bf16x8 __attribute__((ext_vector_type(8)));
    typedef float f32x2v __attribute__((ext_vector_type(2)));
    int tid_ = hw_tid(wv_s); asm volatile("" : "+v"(tid_));
    const int m = tid_, lane = m & 63, wave = __builtin_amdgcn_readfirstlane(m >> 6), l15 = lane & 15, quad = lane >> 4;
    const bf16* F = (const bf16*)(P.ws + WS_RB + (size_t)M * 1024 * 2);
    unsigned* Y = (unsigned*)(P.ws + WS_RA);
    LAS unsigned char* Pl = lds + wave * 16384;
    LAS unsigned char* Dt = lds + 131072;
    LAS f32x2v* ltw = (LAS f32x2v*)(lds + MISC_OFF + 1024);
    for (int i = m; i < 128 * 32; i += NTHREADS) { const int n = i >> 5, j = 2 * (i & 31), mm = n >> 1; float s0, c0, s1, c1;
        sincospif((float)((j * mm) & 63) * (1.0f / 32.0f), &s0, &c0); sincospif((float)(((j + 1) * mm) & 63) * (1.0f / 32.0f), &s1, &c1);
        *(LAS unsigned*)(Dt + n * 128 + j * 2) = (n & 1) ? pk2(-s0, -s1) : pk2(c0, c1); }
    __syncthreads();
    int par = 0;
    for (int item = blockIdx.x; item < 1024 + 256; item += gridDim.x, par ^= 1) {
        int base, N1, t1; const float2* tw;
        if (item < 1024) { base = M_P + (item >> 6) * 4096; t1 = item & 63; N1 = 64; tw = (const float2*)(P.ws + WS_TW4); }
        else { const int it = item - 1024; base = (it >> 5) * 2048; t1 = it & 31; N1 = 32; tw = (const float2*)(P.ws + WS_TW2); }
        if (m < 64) { const float2 w0 = tw[m * t1]; ltw[par * 64 + m] = (f32x2v){w0.x, w0.y}; }
        bf16x8 fb[4][2];
#pragma unroll
        for (int tt = 0; tt < 4; ++tt)
#pragma unroll
            for (int kk = 0; kk < 2; ++kk) fb[tt][kk] = *(const bf16x8*)(F + (size_t)(base + t1 + N1 * (16 * tt + l15)) * 512 + 64 * wave + 32 * kk + 8 * quad);
#pragma unroll
        for (int nt = 0; nt < 8; ++nt) {
            const bf16x8 a0 = *(const LAS bf16x8*)(Dt + (16 * nt + l15) * 128 + (8 * quad) * 2), a1 = *(const LAS bf16x8*)(Dt + (16 * nt + l15) * 128 + (32 + 8 * quad) * 2);
#pragma unroll
            for (int tt = 0; tt < 4; ++tt) {
                f32x4 acc = {0.f, 0.f, 0.f, 0.f};
                acc = __builtin_amdgcn_mfma_f32_16x16x32_bf16(a0, fb[tt][0], acc, 0, 0, 0);
                acc = __builtin_amdgcn_mfma_f32_16x16x32_bf16(a1, fb[tt][1], acc, 0, 0, 0);
                v2u w; w.x = cvtpk_native(acc[0], acc[1]); w.y = cvtpk_native(acc[2], acc[3]);
                *(LAS v2u*)(Pl + (16 * tt + l15) * 256 + (16 * nt + 4 * quad) * 2) = w;
            }
        }
        asm volatile("s_waitcnt lgkmcnt(0)" ::: "memory");
        float re[64], im[64];
#pragma unroll
        for (int t2 = 0; t2 < 64; ++t2) { const unsigned v = *(const LAS unsigned*)(Pl + t2 * 256 + lane * 4); re[t2] = bf_lo(v); im[t2] = bf_hi(v); }
        fft_dif<64>(re, im);
        __syncthreads();
        int base2 = base; asm volatile("" : "+s"(base2));
#pragma unroll
        for (int i = 0; i < 64; ++i) { const int k2 = brev<64>(i); const f32x2v w = ltw[par * 64 + k2];
            const float yr = re[i] * w.x - im[i] * w.y, yi = re[i] * w.y + im[i] * w.x;
            Y[(size_t)(base2 + t1 * 64 + k2) * 512 + m] = pk2(yr, yi); }
    }
}
template <int N1> __device__ __forceinline__ void f2_fft_part(const Params& P, const int wv_s, int l, int base, int k2, LAS float* red, LAS float* rinv) {
    int tid_ = hw_tid(wv_s); asm volatile("" : "+v"(tid_));
    const int m = tid_, lane = m & 63, wave = __builtin_amdgcn_readfirstlane(m >> 6);
    const unsigned* Y = (const unsigned*)(P.ws + WS_RA);
    bf16* MG = (bf16*)(P.ws + WS_RB + (size_t)M * 1024 * 2);
    unsigned raw[N1]; const unsigned moff = (unsigned)m * 4u;
#pragma unroll
    for (int t1 = 0; t1 < N1; ++t1) raw[t1] = gload_row((const char*)Y + (size_t)(base + t1 * 64 + k2) * 2048, moff);
    asm volatile("s_waitcnt vmcnt(0)" ::: "memory");
    TIE16(raw, 0); TIE16(raw, 16); if constexpr (N1 == 64) { TIE16(raw, 32); TIE16(raw, 48); }
    float re[N1], im[N1];
#pragma unroll
    for (int t1 = 0; t1 < N1; ++t1) { re[t1] = bf_lo(raw[t1]); im[t1] = bf_hi(raw[t1]); }
    fft_dif<N1>(re, im);
#pragma unroll
    for (int i = 0; i < N1; ++i) { const float s = wave_sum_dpp(re[i] * re[i]); if (lane == 0) red[wave * 64 + i] = s; }
    __syncthreads();
    if (m < N1) { float s = 0.f;
#pragma unroll
        for (int w = 0; w < NWAVES; ++w) s += red[w * 64 + m];
        rinv[m] = rsqrtf(s * (1.0f / 512.0f) + EPS); }
    __syncthreads();
    const float g = P.in[12][l * 512 + m];
    int base2 = base; asm volatile("" : "+s"(base2));
#pragma unroll
    for (int i = 0; i < N1; ++i) { const int k1 = brev<N1>(i); const float v = re[i] * rinv[i] * g;
        MG[(size_t)(base2 + 64 * k1 + k2) * 1024 + 512 + m] = (bf16)(pk2(v, 0.f) & 0xffffu); if ((i & 7) == 7) __builtin_amdgcn_sched_barrier(0); }
    __syncthreads();
}
__device__ __forceinline__ void f2_phase(const Params& P, int l, LAS unsigned char* lds, const int wv_s) {
    int tid_ = hw_tid(wv_s); asm volatile("" : "+v"(tid_));
    const int lane = tid_ & 63, wave = __builtin_amdgcn_readfirstlane(tid_ >> 6);
    LAS float* red = (LAS float*)lds; LAS float* rinv = red + 512;
    const bf16* BG = (const bf16*)(P.ws + WS_RB); const bf16* U = BG + (size_t)M * 512;
    bf16* MG = (bf16*)(P.ws + WS_RB + (size_t)M * 1024 * 2);
    for (int item = blockIdx.x; item < 1024 + 512; item += gridDim.x) {
        int base, N1, k2, S;
        if (item < 1024) { base = M_P + (item >> 6) * 4096; k2 = item & 63; N1 = 64; S = 4096; f2_fft_part<64>(P, wv_s, l, base, k2, red, rinv); }
        else { const int it = item - 1024; base = (it >> 6) * 2048; k2 = it & 63; N1 = 32; S = 2048; f2_fft_part<32>(P, wv_s, l, base, k2, red, rinv); }
        f32x4 cw[3][2], cb[2], gc[2];
#pragma unroll
        for (int h = 0; h < 2; ++h) {
#pragma unroll
            for (int t = 0; t < 3; ++t) cw[t][h] = *(const f32x4*)(P.in[9] + (size_t)l * 3 * 512 + t * 512 + 8 * lane + 4 * h);
            cb[h] = *(const f32x4*)(P.in[10] + l * 512 + 8 * lane + 4 * h); gc[h] = *(const f32x4*)(P.in[11] + l * 512 + 8 * lane + 4 * h); }
        for (int kb = 0; kb < N1 / NWAVES; kb += 4) {
            v4u bgv[4], u0[4], um[4], up[4];
#pragma unroll
            for (int q = 0; q < 4; ++q) { const int t = 64 * (wave + NWAVES * (kb + q)) + k2; const size_t row = (size_t)(base + t); const v4u zero = {0u, 0u, 0u, 0u};
                bgv[q] = *(const v4u*)(BG + row * 512 + 8 * lane); u0[q] = *(const v4u*)(U + row * 512 + 8 * lane);
                um[q] = t > 0 ? *(const v4u*)(U + (row - 1) * 512 + 8 * lane) : zero; up[q] = t < S - 1 ? *(const v4u*)(U + (row + 1) * 512 + 8 * lane) : zero; }
#pragma unroll
            for (int q = 0; q < 4; ++q) { const int t = 64 * (wave + NWAVES * (kb + q)) + k2; const size_t row = (size_t)(base + t);
                float co[8]; float ss = 0.f;
#pragma unroll
                for (int e = 0; e < 4; ++e) {
                    const int h = e >> 1, c0 = 2 * (e & 1);
                    const float a0 = cw[0][h][c0] * bf_lo(um[q][e]) + cw[1][h][c0] * bf_lo(u0[q][e]) + cw[2][h][c0] * bf_lo(up[q][e]) + cb[h][c0];
                    const float a1 = cw[0][h][c0 + 1] * bf_hi(um[q][e]) + cw[1][h][c0 + 1] * bf_hi(u0[q][e]) + cw[2][h][c0 + 1] * bf_hi(up[q][e]) + cb[h][c0 + 1];
                    co[2 * e] = bf_lo(bgv[q][e]) * a0; co[2 * e + 1] = bf_hi(bgv[q][e]) * a1; ss += co[2 * e] * co[2 * e] + co[2 * e + 1] * co[2 * e + 1];
                }
                ss = wave_sum_dpp(ss);
                const float ri = rsqrtf(ss * (1.0f / 512.0f) + EPS);
                v4u w;
#pragma unroll
                for (int e = 0; e < 4; ++e) { const int h = e >> 1, c0 = 2 * (e & 1); w[e] = pk2(co[2 * e] * ri * gc[h][c0], co[2 * e + 1] * ri * gc[h][c0 + 1]); }
                *(v4u*)(MG + row * 1024 + 8 * lane) = w; }
        }
    }
}

#ifndef EFUSE
#define EFUSE 1
#endif
__device__ __forceinline__ bool panel_exchange(float part  , const int tid, float* slots, unsigned* cnt, const int pm, const int pn, LAS float* S, const float inv_n) {
    if (tid < 256) {
        __hip_atomic_store(slots + ((size_t)(pm * 256 + tid)) * 4 + pn, part, __ATOMIC_RELAXED, __HIP_MEMORY_SCOPE_AGENT);
        asm volatile("s_waitcnt vmcnt(0)" ::: "memory");
        if ((tid & 63) == 0) __hip_atomic_fetch_add(cnt + 64 * pm, 1u, __ATOMIC_RELAXED, __HIP_MEMORY_SCOPE_AGENT);
    }
    if (tid == 0) { unsigned sp = 0u;
        while (__hip_atomic_load(cnt + 64 * pm, __ATOMIC_RELAXED, __HIP_MEMORY_SCOPE_AGENT) < 16u) { __builtin_amdgcn_s_sleep(1); if (++sp > (1u << 22)) break; } }
    __syncthreads();
    if (tid < 256) { const float* q = slots + ((size_t)(pm * 256 + tid)) * 4;
        const float t = (__hip_atomic_load(q + 0, __ATOMIC_RELAXED, __HIP_MEMORY_SCOPE_AGENT) + __hip_atomic_load(q + 1, __ATOMIC_RELAXED, __HIP_MEMORY_SCOPE_AGENT))
                      + (__hip_atomic_load(q + 2, __ATOMIC_RELAXED, __HIP_MEMORY_SCOPE_AGENT) + __hip_atomic_load(q + 3, __ATOMIC_RELAXED, __HIP_MEMORY_SCOPE_AGENT));
        S[tid] = rsqrtf(t * inv_n + EPS); }
    __syncthreads();
    return true;
}
template <bool DOH, bool LAST, bool FIRST> struct EpiFuse {
    static constexpr bool PERM = true, AFTER_DRAIN = false;
    const Params* P; LAS unsigned char* lds; int wv_s, inst;
    const float *gpost, *modg, *gpre, *modsh, *modsc;
    __device__ __forceinline__ void operator()(const pg8::f32x4 (&acc_c)[2][2][4][2], const pg8::Unit& u, int wr, int wc, int fr, int fq) const {
        typedef pg8::f32x4 (&AccRef)[2][2][4][2];
        AccRef acc = const_cast<AccRef>(acc_c);
        const int ln = fq * 16 + fr, tid = wv_s * 64 + ln;
        LAS float* Pt = (LAS float*)(lds + 131072);
        LAS float* S = (LAS float*)(lds + 131072 + 4096);
        unsigned char* ws = P->ws;
        float* slots = (float*)(ws + WS_SLOT) + (size_t)(2 * inst) * M * 4; unsigned* cnt = (unsigned*)(ws + WS_CNT) + (size_t)(2 * inst) * 320 * 64;
        const int row0 = u.pm * 256 + wr * 64 + fr, cl = u.pn * 256 + wc * 32 + 8 * fq, gbt = row_batch(u.pm * 256);
        bf16* XB = (bf16*)(ws + WS_XB); bf16* RA = (bf16*)(ws + WS_RA);
#pragma unroll
        for (int ai = 0; ai < 2; ++ai)
#pragma unroll
            for (int m = 0; m < 4; ++m) { float sq = 0.f;
#pragma unroll
                for (int bj = 0; bj < 2; ++bj)
#pragma unroll
                    for (int n = 0; n < 2; ++n) { const pg8::f32x4 a = acc[ai][bj][m][n]; sq += (a[0] * a[0] + a[1] * a[1]) + (a[2] * a[2] + a[3] * a[3]); }
                sq += __int_as_float(__builtin_amdgcn_ds_bpermute((ln ^ 16) << 2, __float_as_int(sq))); sq += __int_as_float(__builtin_amdgcn_ds_bpermute((ln ^ 32) << 2, __float_as_int(sq)));
                if (fq == 0) Pt[(ai * 128 + wr * 64 + m * 16 + fr) * 4 + wc] = sq; }
        __syncthreads();
        float part = 0.f;
        if (tid < 256) { const pg8::f32x4 t4 = *(const LAS pg8::f32x4*)(Pt + tid * 4); part = (t4[0] + t4[1]) + (t4[2] + t4[3]); }
        panel_exchange(part, tid, slots, cnt, u.pm, u.pn, S, 1.0f / D);
        pg8::f32x4 gb[2][2];
#pragma unroll
        for (int bj = 0; bj < 2; ++bj)
#pragma unroll
            for (int n = 0; n < 2; ++n) gb[bj][n] = *(const pg8::f32x4*)(modg + (size_t)gbt * 6144 + cl + 128 * bj + 4 * n) * *(const pg8::f32x4*)(gpost + cl + 128 * bj + 4 * n);
        float s2[2][4];
        constexpr int NCH = FIRST ? 4 : 2, MPC = 8 / NCH;
#pragma unroll
        for (int aih = 0; aih < NCH; ++aih) { const int ai = aih / (NCH / 2), mb = (aih % (NCH / 2)) * MPC;
            pg8::u32x4 xb[4][2]; pg8::f32x4 xf[4][2][2];
#pragma unroll
            for (int m = mb; m < mb + MPC; ++m)
#pragma unroll
                for (int bj = 0; bj < 2; ++bj) { const int row = row0 + ai * 128 + m * 16;
                    if (FIRST) { const float* xr = (row < M_P ? P->in[0] + (size_t)row * D : P->in[1] + (size_t)(row - M_P) * D) + cl + 128 * bj; xf[m][bj][0] = *(const pg8::f32x4*)xr; xf[m][bj][1] = *(const pg8::f32x4*)(xr + 4); }
                    else xb[m][bj] = *(const pg8::u32x4*)(XB + (size_t)row * D + cl + 128 * bj); }
#pragma unroll
            for (int m = mb; m < mb + MPC; ++m) { const int row = row0 + ai * 128 + m * 16; const float rinv = S[ai * 128 + wr * 64 + m * 16 + fr]; float sq = 0.f;
#pragma unroll
                for (int bj = 0; bj < 2; ++bj) {
                    pg8::f32x4 x0, x1;
                    if (FIRST) { x0 = xf[m][bj][0]; x1 = xf[m][bj][1]; }
                    else { const pg8::u32x4 w = xb[m][bj]; x0 = (pg8::f32x4){bf_lo(w.x), bf_hi(w.x), bf_lo(w.y), bf_hi(w.y)}; x1 = (pg8::f32x4){bf_lo(w.z), bf_hi(w.z), bf_lo(w.w), bf_hi(w.w)}; }
                    x0 += gb[bj][0] * (acc[ai][bj][m][0] * rinv); x1 += gb[bj][1] * (acc[ai][bj][m][1] * rinv);
                    if (LAST) { float* orow = P->out + (size_t)row * D + cl + 128 * bj; *(pg8::f32x4*)orow = x0; *(pg8::f32x4*)(orow + 4) = x1; }
                    else { pg8::u32x4 w; w.x = cvtpk_native(x0[0], x0[1]); w.y = cvtpk_native(x0[2], x0[3]); w.z = cvtpk_native(x1[0], x1[1]); w.w = cvtpk_native(x1[2], x1[3]);
                        *(pg8::u32x4*)(XB + (size_t)row * D + cl + 128 * bj) = w;
                        x0 = (pg8::f32x4){bf_lo(w.x), bf_hi(w.x), bf_lo(w.y), bf_hi(w.y)}; x1 = (pg8::f32x4){bf_lo(w.z), bf_hi(w.z), bf_lo(w.w), bf_hi(w.w)}; }
                    acc[ai][bj][m][0] = x0; acc[ai][bj][m][1] = x1;
                    sq += ((x0[0] * x0[0] + x0[1] * x0[1]) + (x0[2] * x0[2] + x0[3] * x0[3])) + ((x1[0] * x1[0] + x1[1] * x1[1]) + (x1[2] * x1[2] + x1[3] * x1[3]));
                }
                s2[ai][m] = sq; }
        }
        if (DOH) {
#pragma unroll
            for (int ai = 0; ai < 2; ++ai)
#pragma unroll
                for (int m = 0; m < 4; ++m) { float sq = s2[ai][m];
                    sq += __int_as_float(__builtin_amdgcn_ds_bpermute((ln ^ 16) << 2, __float_as_int(sq))); sq += __int_as_float(__builtin_amdgcn_ds_bpermute((ln ^ 32) << 2, __float_as_int(sq)));
                    if (fq == 0) Pt[(ai * 128 + wr * 64 + m * 16 + fr) * 4 + wc] = sq; }
            __syncthreads();
            float part2 = 0.f;
            if (tid < 256) { const pg8::f32x4 t4 = *(const LAS pg8::f32x4*)(Pt + tid * 4); part2 = (t4[0] + t4[1]) + (t4[2] + t4[3]); }
            panel_exchange(part2, tid, slots + (size_t)M * 4, cnt + 320 * 64, u.pm, u.pn, S, 1.0f / D);
            pg8::f32x4 ga[2][2], sh[2][2];
#pragma unroll
            for (int bj = 0; bj < 2; ++bj)
#pragma unroll
                for (int n = 0; n < 2; ++n) { const int c = cl + 128 * bj + 4 * n;
                    ga[bj][n] = (*(const pg8::f32x4*)(modsc + (size_t)gbt * 6144 + c) + 1.0f) * *(const pg8::f32x4*)(gpre + c); sh[bj][n] = *(const pg8::f32x4*)(modsh + (size_t)gbt * 6144 + c); }
#pragma unroll
            for (int ai = 0; ai < 2; ++ai)
#pragma unroll
                for (int m = 0; m < 4; ++m) { const int row = row0 + ai * 128 + m * 16; const float r2 = S[ai * 128 + wr * 64 + m * 16 + fr];
#pragma unroll
                    for (int bj = 0; bj < 2; ++bj) { const pg8::f32x4 h0 = (acc[ai][bj][m][0] * r2) * ga[bj][0] + sh[bj][0], h1 = (acc[ai][bj][m][1] * r2) * ga[bj][1] + sh[bj][1];
                        pg8::u32x4 w; w.x = cvtpk_native(h0[0], h0[1]); w.y = cvtpk_native(h0[2], h0[3]); w.z = cvtpk_native(h1[0], h1[1]); w.w = cvtpk_native(h1[2], h1[3]);
                        *(pg8::u32x4*)(RA + (size_t)row * D + cl + 128 * bj) = w; } }
        }
        __syncthreads();
    }
};
#define XB_TMO      128
#define XB_XCNT(j)  (256  + 64 * (j))
#define XB_XSUB(j)  (1280 + 64 * (j))
#define XB_XGEN(j)  (2304 + 64 * (j))
#define XB_TOP      3328
#define XB_TOPGEN   3392
#define XCD_BAR_WORDS 3456
#define XB_SPIN_CAP (1u << 18)

__device__ __forceinline__ unsigned xb_ld(unsigned* p)              { return __hip_atomic_load(p, __ATOMIC_RELAXED, __HIP_MEMORY_SCOPE_AGENT); }
__device__ __forceinline__ unsigned xb_add(unsigned* p, unsigned v) { return __hip_atomic_fetch_add(p, v, __ATOMIC_RELAXED, __HIP_MEMORY_SCOPE_AGENT); }
__device__ __forceinline__ unsigned xb_xcc_id() { return (unsigned)__builtin_amdgcn_s_getreg((3 << 11) | 20) & 0xFu; }
#define XB_SPIN(cond, bar) do { unsigned _sp = 0; while (cond) { __builtin_amdgcn_s_sleep(1); \
    if ((++_sp & 255u) == 0u) { if (xb_ld(&(bar)[XB_TMO])) break; if (_sp > XB_SPIN_CAP) { atomicAdd(&(bar)[XB_TMO], 1u); break; } } } } while (0)

struct XcdBarrier {
    unsigned* bar; unsigned x;
    volatile LAS unsigned* st;
};

__device__ __forceinline__ XcdBarrier xcd_barrier_post(unsigned* bar, volatile LAS unsigned* st) {
    XcdBarrier b; b.bar = bar; b.x = xb_xcc_id(); b.st = st;
    if (threadIdx.x == 0) (void)xb_add(&bar[XB_XCNT(b.x)], 1u);
    return b;
}
__device__ __forceinline__ void xcd_barrier_complete(unsigned* bar, unsigned x, unsigned& nloc, unsigned& nx) {
    const unsigned G = gridDim.x * gridDim.y * gridDim.z;
    unsigned sum, cnt, mine, sp = 0u;
    for (;;) {
        sum = 0u; cnt = 0u; mine = 0u;
#pragma unroll
        for (unsigned j = 0; j < 16; ++j) { const unsigned c = xb_ld(&bar[XB_XCNT(j)]); sum += c; cnt += (c > 0u) ? 1u : 0u; mine = (j == x) ? c : mine; }
        if (sum == G) break;
        __builtin_amdgcn_s_sleep(1);
        if ((++sp & 255u) == 0u) { if (xb_ld(&bar[XB_TMO])) break; if (sp > XB_SPIN_CAP) { atomicAdd(&bar[XB_TMO], 1u); break; } }
    }
    nloc = mine > 0u ? mine : 1u; nx = cnt > 0u ? cnt : 1u;
}

__device__ __forceinline__ void xcd_barrier(const XcdBarrier& b) {
    asm volatile("s_waitcnt vmcnt(0)" ::: "memory");
    __syncthreads();
    if (threadIdx.x == 0) {
        unsigned* bar = b.bar;
        __builtin_amdgcn_s_waitcnt(0);
        unsigned nloc = b.st[0], nx = b.st[1];
        if (nloc == 0u) { xcd_barrier_complete(bar, b.x, nloc, nx); b.st[0] = nloc; b.st[1] = nx; }
        const unsigned old = xb_add(&bar[XB_XSUB(b.x)], 1u);
        const unsigned gen = old / nloc;
        if (old + 1u == (gen + 1u) * nloc) {
            __builtin_amdgcn_fence(__ATOMIC_RELEASE, "agent");
            asm volatile("s_waitcnt vmcnt(0)" ::: "memory");
            const unsigned og = xb_add(&bar[XB_TOP], 1u);
            const unsigned tg = og / nx;
            if (og + 1u == (tg + 1u) * nx) xb_add(&bar[XB_TOPGEN], 1u);
            else XB_SPIN(xb_ld(&bar[XB_TOPGEN]) == tg, bar);
            __builtin_amdgcn_fence(__ATOMIC_ACQUIRE, "agent");
            xb_add(&bar[XB_XGEN(b.x)], 1u);
            asm volatile("s_waitcnt vmcnt(0)" ::: "memory");
        } else {
            XB_SPIN(xb_ld(&bar[XB_XGEN(b.x)]) == gen, bar);
            __builtin_amdgcn_fence(__ATOMIC_ACQUIRE, "agent");
            asm volatile("s_waitcnt vmcnt(0)" ::: "memory");
        }
    }
    __syncthreads();
}

#ifndef REP_P0
#define REP_P0 0
#endif
#ifndef REP_SYNC
#define REP_SYNC 0
#endif
#ifndef REP_N0
#define REP_N0 0
#endif
#ifndef RFUSE
#define RFUSE 0
#endif
#ifndef REPMASK
#define REPMASK 0
#endif
#ifndef PHM
#define PHM 0xffff
#endif
struct RevOrder : pg8::StaticOrder { __device__ __forceinline__ bool next(int i, pg8::Unit& u) const { const bool r = pg8::StaticOrder::next(i, u); u.pm = nM - 1 - u.pm; return r; } };
constexpr int N_PHASES = 2 + 8 * DEPTH;
__global__ void __launch_bounds__(NTHREADS, 2) fwd_kernel(Params P) {
    extern __shared__ __attribute__((aligned(16))) unsigned char lds_raw[];
    LAS unsigned char* lds = (LAS unsigned char*)lds_raw;
    const int wv_s = __builtin_amdgcn_readfirstlane(threadIdx.x >> 6);
    unsigned char* ws = P.ws;
    const float* mod = (const float*)(ws + WS_MOD);
    bf16* RA = (bf16*)(ws + WS_RA); bf16* RB = (bf16*)(ws + WS_RB);
    float* stats = (float*)(ws + WS_STATS);
    volatile LAS unsigned* bst = (volatile LAS unsigned*)(lds + MISC_OFF + 512);
    if (threadIdx.x == 0) { bst[0] = 0u; bst[1] = 0u; }
    __syncthreads();
    XcdBarrier bar; bar.bar = (unsigned*)(ws + WS_BAR); bar.x = 0; bar.st = bst;
    for (int ph = P.ph_lo; ph < P.ph_hi; ++ph) {
        if (ph == 0) p0_prep(P, lds, wv_s);
        else if (ph == 1) { p0_weights(P, lds, wv_s); row_phase<false, true, false, true>(P, wv_s, nullptr, nullptr, P.in[6], mod + 0 * D, mod + 1 * D); }
        else {
            const int l = (ph - 2) >> 3, s = (ph - 2) & 7;
            const float* modl = mod + (size_t)l * NB * 6144;
            const bool fuse = EFUSE && XBF16 && gridDim.x == 256;
            if (fuse && (s == 4 || s == 7)) continue;
            if (s == 0) { pg8::Gemm g{RA, (const bf16*)(ws + WS_WIN) + (size_t)l * N_IN * D, M, N_IN, D}; pg8::StaticOrder S; S.init(M, N_IN, gridDim.x, blockIdx.x);
                pg8::EpiIn E{RB, RB + (size_t)M * 512, RB + (size_t)M * 1024};
                pg8::gemm_phase<pg8::EpiIn, pg8::StaticOrder, true, true>(lds, g, S, E, wv_s); }
            else if (s == 1) f1_phase(P, lds, wv_s);
            else if (s == 2) f2_phase(P, l, lds, wv_s);
            else if (s == 3) { pg8::Gemm g{RB + (size_t)M * 1024, (const bf16*)(ws + WS_WOUT) + (size_t)l * D * D, M, D, D}; pg8::StaticOrder S; S.init(M, D, gridDim.x, blockIdx.x);
                if (fuse) {
                    if (l == 0) { EpiFuse<true, false, true> E{&P, lds, wv_s, 2 * l, P.in[7] + l * D, modl + 2 * D, P.in[14] + l * D, modl + 3 * D, modl + 4 * D};
                        pg8::gemm_phase<EpiFuse<true, false, true>, pg8::StaticOrder, true, true>(lds, g, S, E, wv_s); }
                    else { EpiFuse<true, false, false> E{&P, lds, wv_s, 2 * l, P.in[7] + l * D, modl + 2 * D, P.in[14] + l * D, modl + 3 * D, modl + 4 * D};
                        pg8::gemm_phase<EpiFuse<true, false, false>, pg8::StaticOrder, true, true>(lds, g, S, E, wv_s); } }
                else { pg8::EpiOS E{RA, stats};
                pg8::gemm_phase<pg8::EpiOS, pg8::StaticOrder, true, true>(lds, g, S, E, wv_s); } }
            else if (s == 4) { if (l == 0) row_phase<true, true, false, true>(P, wv_s, P.in[7] + l * D, modl + 2 * D, P.in[14] + l * D, modl + 3 * D, modl + 4 * D);
                               else row_phase<true, true, false, false>(P, wv_s, P.in[7] + l * D, modl + 2 * D, P.in[14] + l * D, modl + 3 * D, modl + 4 * D); }
            else if (s == 5) { pg8::Gemm g{RA, (const bf16*)(ws + WS_WGU) + (size_t)l * N_GU * D, M, N_GU, D}; pg8::StaticOrder S; S.init(M, N_GU, gridDim.x, blockIdx.x);
                pg8::EpiAct E{RB};
                pg8::gemm_phase<pg8::EpiAct, pg8::StaticOrder, true, true>(lds, g, S, E, wv_s); }
            else if (s == 6) { pg8::Gemm g{RB, (const bf16*)(ws + WS_WDN) + (size_t)l * D * DFF, M, D, DFF}; RevOrder S; S.init(M, D, gridDim.x, blockIdx.x);
                if (fuse) {
                    if (l < DEPTH - 1) { EpiFuse<true, false, false> E{&P, lds, wv_s, 2 * l + 1, P.in[15] + l * D, modl + 5 * D, P.in[6] + (l + 1) * D, modl + NB * 6144 + 0 * D, modl + NB * 6144 + 1 * D};
                        pg8::gemm_phase<EpiFuse<true, false, false>, RevOrder, true, true>(lds, g, S, E, wv_s); }
                    else { EpiFuse<false, true, false> E{&P, lds, wv_s, 2 * l + 1, P.in[15] + l * D, modl + 5 * D, nullptr, nullptr, nullptr};
                        pg8::gemm_phase<EpiFuse<false, true, false>, RevOrder, true, true>(lds, g, S, E, wv_s); } }
                else { pg8::EpiOS E{RA, stats};
                pg8::gemm_phase<pg8::EpiOS, RevOrder, true, true>(lds, g, S, E, wv_s); } }
            else { if (l < DEPTH - 1) row_phase<true, true, false, false>(P, wv_s, P.in[15] + l * D, modl + 5 * D, P.in[6] + (l + 1) * D, modl + NB * 6144 + 0 * D, modl + NB * 6144 + 1 * D);
                   else row_phase<true, false, true, false>(P, wv_s, P.in[15] + l * D, modl + 5 * D, nullptr, nullptr, nullptr); }
        }
        if (ph + 1 < P.ph_hi) {
            if (ph == 0) { __syncthreads(); cg::this_grid().sync(); bar = xcd_barrier_post((unsigned*)(ws + WS_BAR), bst); }
            else xcd_barrier(bar);
        }
    }
}

extern "C" void kernel_launch(void* const* d_in, const int* in_sizes, int n_in, void* d_out, int out_size, void* d_ws, size_t ws_size, hipStream_t stream) {
    static int grid = 0;
    if (!grid) {
        int dev = 0, cus = 0, per_cu = 0;
        hipGetDevice(&dev); hipDeviceGetAttribute(&cus, hipDeviceAttributeMultiprocessorCount, dev);
        if (hipFuncSetAttribute((const void*)fwd_kernel, hipFuncAttributeMaxDynamicSharedMemorySize, LDS_BYTES) != hipSuccess) fprintf(stderr, "kernel_launch: hipFuncSetAttribute failed\n");
        if (hipOccupancyMaxActiveBlocksPerMultiprocessor(&per_cu, (const void*)fwd_kernel, NTHREADS, LDS_BYTES) != hipSuccess || per_cu < 1) { fprintf(stderr, "kernel_launch: occupancy query says %d\n", per_cu); per_cu = 1; }
        grid = cus > 0 ? cus : 256;
        if (n_in != 19 || ws_size < WS_END) fprintf(stderr, "kernel_launch: unexpected n_in %d / ws_size %zu (need %zu)\n", n_in, ws_size, (size_t)WS_END);
    }
    Params p{};
    for (int i = 0; i < 19; ++i) p.in[i] = (const float*)d_in[i];
    p.out = (float*)d_out; p.ws = (unsigned char*)d_ws;
#if MK_ONE_LAUNCH
    p.ph_lo = 0; p.ph_hi = N_PHASES;
    void* args[] = {&p};
    hipError_t e = hipLaunchCooperativeKernel((const void*)fwd_kernel, dim3(grid), dim3(NTHREADS), args, LDS_BYTES, stream);
    if (e != hipSuccess) fprintf(stderr, "kernel_launch: cooperative launch failed: %s (grid %d)\n", hipGetErrorString(e), grid);
#else
    for (int ph = 0; ph < N_PHASES; ++ph) { p.ph_lo = ph; p.ph_hi = ph + 1; hipLaunchKernelGGL(fwd_kernel, dim3(grid), dim3(NTHREADS), LDS_BYTES, stream, p); }
#endif
}
```
